# Optimizing an MI355X kernel written in HIP

```python
import math
import jax
import jax.numpy as jnp
from jax import lax
import numpy as np

D_MODEL = 2048
BATCH = 4
SEQ = 2048
DEPTH = 2

GRID_W = 64
CTX_LEN = 256

D_SSM = D_MODEL // 2
SSM_HEAD_DIM = 64
SSM_HEADS = D_SSM // SSM_HEAD_DIM
SSM_GROUPS = 4
SSM_STATE = 128
SSM_CONV = 5
SSM_CHUNK = 128
D_XBC = D_SSM + 2 * SSM_GROUPS * SSM_STATE

DIFF_HEAD_DIM = 64
DIFF_HEADS = (D_MODEL // 2) // (2 * DIFF_HEAD_DIM)
D_QK_DIFF = 2 * DIFF_HEADS * DIFF_HEAD_DIM
D_V_DIFF = DIFF_HEADS * 2 * DIFF_HEAD_DIM

D_MIX_EVEN = D_SSM + D_V_DIFF
IN_EVEN = D_SSM + D_XBC + 2 * SSM_HEADS + 2 * D_QK_DIFF + D_V_DIFF

NA_HEAD_DIM = 128
NA_HEADS = D_MODEL // NA_HEAD_DIM
D_NA = NA_HEADS * NA_HEAD_DIM
WIN_ROWS = 8
WIN_COLS = 16

D_FF = ((8 * D_MODEL // 3 + 255) // 256) * 256

N_EVEN = (DEPTH + 1) // 2
N_ODD = DEPTH // 2

QUERY_BLOCK = 128
ROPE_BASE = 10000.0
NORM_EPS = 1e-6

kernel_name = 'hybrid_ssd_diffattn_natten_prefix_dit'


def rms_norm(x, g):
    xf = x.astype(jnp.float32)
    xf = xf * lax.rsqrt(jnp.mean(xf * xf, axis=-1, keepdims=True) + NORM_EPS)
    return (xf * g.astype(jnp.float32)).astype(x.dtype)


def modulate(h, shift, scale):
    return h * (1.0 + scale) + shift


def swiglu(h, w1, w3, w2):
    return (jax.nn.silu(h @ w1) * (h @ w3)) @ w2


def axial_rope(x, row, col):
    half = x.shape[-1] // 2
    inv_freq = ROPE_BASE ** (-jnp.arange(0, half, 2, dtype=jnp.float32) / half)

    def rot(u, p):
        ang = p.astype(jnp.float32)[:, None] * inv_freq[None, :]
        cos = jnp.cos(ang)[None, :, None, :].astype(u.dtype)
        sin = jnp.sin(ang)[None, :, None, :].astype(u.dtype)
        u1, u2 = jnp.split(u, 2, axis=-1)
        return jnp.concatenate([u1 * cos - u2 * sin, u1 * sin + u2 * cos], axis=-1)

    xr, xc = jnp.split(x, 2, axis=-1)
    return jnp.concatenate([rot(xr, row), rot(xc, col)], axis=-1)


def depthwise_conv_centred(u, w, bias):
    k_w = w.shape[0]
    n = u.shape[1]
    up = jnp.pad(u, ((0, 0), (k_w // 2, k_w // 2), (0, 0)))
    return sum(up[:, t:t + n] * w[t] for t in range(k_w)) + bias


def ssd_chunked_scan(xs, dt, a, bm, cm, h0):
    b, n, nh, hp = xs.shape
    ng, ns = bm.shape[2], bm.shape[3]
    nc = n // SSM_CHUNK
    rep = nh // ng
    bh = jnp.repeat(bm, rep, axis=2).reshape(b, nc, SSM_CHUNK, nh, ns)
    ch = jnp.repeat(cm, rep, axis=2).reshape(b, nc, SSM_CHUNK, nh, ns)
    xdt = (xs * dt[..., None]).reshape(b, nc, SSM_CHUNK, nh, hp)
    a_cum = jnp.cumsum((dt * a).astype(jnp.float32).reshape(b, nc, SSM_CHUNK, nh), axis=2)

    lower = jnp.tril(jnp.ones((SSM_CHUNK, SSM_CHUNK), dtype=bool))
    seg = a_cum[:, :, :, None, :] - a_cum[:, :, None, :, :]
    decay_ls = jnp.exp(jnp.where(lower[None, None, :, :, None], seg, -jnp.inf)).astype(xs.dtype)
    cb = jnp.einsum('bclhn,bcshn->bclsh', ch, bh) * decay_ls
    y_diag = jnp.einsum('bclsh,bcshp->bclhp', cb, xdt)

    decay_to_end = jnp.exp(a_cum[:, :, -1:, :] - a_cum).astype(xs.dtype)
    chunk_states = jnp.einsum('bclhn,bclhp->bchpn', bh * decay_to_end[..., None], xdt)
    chunk_decay = jnp.exp(a_cum[:, :, -1, :]).astype(xs.dtype)

    def carry_state(h, inp):
        s_c, d_c = inp
        return h * d_c[:, :, None, None] + s_c, h

    h_final, h_start = lax.scan(carry_state, h0,
                                (jnp.moveaxis(chunk_states, 1, 0), jnp.moveaxis(chunk_decay, 1, 0)))
    h_start = jnp.moveaxis(h_start, 0, 1)
    y_off = jnp.einsum('bclhn,bchpn->bclhp', ch * jnp.exp(a_cum).astype(xs.dtype)[..., None], h_start)
    return (y_diag + y_off).reshape(b, n, nh, hp), h_final


def ssd_bidirectional(xs, dt_f, dt_b, a_f, a_b, bm, cm, h0_f, h0_b):
    flip = lambda t: jnp.flip(t, axis=1)
    y_f, h_f = ssd_chunked_scan(xs, dt_f, a_f, bm, cm, h0_f)
    y_b, h_b = ssd_chunked_scan(flip(xs), flip(dt_b), a_b, flip(bm), flip(cm), h0_b)
    return y_f + flip(y_b), h_f, h_b


def diff_attend(q, k, v, lam):
    b, nq, h2, d = q.shape
    s = jnp.einsum('bqhd,bkhd->bhqk', q, k).astype(jnp.float32) * (d ** -0.5)
    p = jax.nn.softmax(s, axis=-1).reshape(b, h2 // 2, 2, nq, k.shape[1])
    pd = (p[:, :, 0] - lam * p[:, :, 1]).astype(v.dtype)
    return jnp.einsum('bhqk,bkhe->bqhe', pd, v)


def softmax_attention(q, k, v):
    s = jnp.einsum('bqhd,bkhd->bhqk', q, k).astype(jnp.float32) * (q.shape[-1] ** -0.5)
    p = jax.nn.softmax(s, axis=-1).astype(v.dtype)
    return jnp.einsum('bhqk,bkhd->bqhd', p, v)


def blocked_queries(fn, q):
    b, n = q.shape[:2]
    nb = n // QUERY_BLOCK
    qb = jnp.moveaxis(q.reshape(b, nb, QUERY_BLOCK, *q.shape[2:]), 1, 0)
    out = lax.map(fn, qb)
    return jnp.moveaxis(out, 0, 1).reshape(b, n, *out.shape[3:])


def neighbourhood_attention(q, k, v, k_ctx, v_ctx, rpb):
    b, n, nh, hd = q.shape
    rows = n // GRID_W
    kr = min(WIN_ROWS, rows)
    nw = kr * GRID_W
    scale = hd ** -0.5
    qg = q.reshape(b, rows, GRID_W, nh, hd)
    kg = k.reshape(b, rows, GRID_W, nh, hd)
    vg = v.reshape(b, rows, GRID_W, nh, hd)
    qcol = jnp.arange(GRID_W)
    kcol = jnp.arange(GRID_W)
    col_start = jnp.clip(qcol - WIN_COLS // 2, 0, GRID_W - WIN_COLS)
    col_ok = (kcol[None, :] >= col_start[:, None]) & (kcol[None, :] < col_start[:, None] + WIN_COLS)
    mask = jnp.broadcast_to(col_ok[:, None, :], (GRID_W, kr, GRID_W)).reshape(GRID_W, nw)
    dc_idx = jnp.clip(kcol[None, :] - qcol[:, None] + WIN_COLS - 1, 0, 2 * WIN_COLS - 2)
    rpb_cols = rpb[:, :, dc_idx]

    def row_block(r):
        rs = jnp.clip(r - kr // 2, 0, rows - kr)
        q_r = lax.dynamic_index_in_dim(qg, r, axis=1, keepdims=False)
        k_r = lax.dynamic_slice_in_dim(kg, rs, kr, axis=1).reshape(b, nw, nh, hd)
        v_r = lax.dynamic_slice_in_dim(vg, rs, kr, axis=1).reshape(b, nw, nh, hd)
        dr_idx = rs + jnp.arange(kr) - r + WIN_ROWS - 1
        bias = jnp.moveaxis(rpb_cols[:, dr_idx], 1, 2).reshape(nh, GRID_W, nw)
        s_win = jnp.einsum('bqhd,bkhd->bhqk', q_r, k_r).astype(jnp.float32) * scale + bias.astype(jnp.float32)
        s_win = jnp.where(mask, s_win, -jnp.inf)
        s_ctx = jnp.einsum('bqhd,bkhd->bhqk', q_r, k_ctx).astype(jnp.float32) * scale
        p = jax.nn.softmax(jnp.concatenate([s_win, s_ctx], axis=-1), axis=-1).astype(v.dtype)
        return (jnp.einsum('bhqk,bkhd->bqhd', p[..., :nw], v_r)
                + jnp.einsum('bhqk,bkhd->bqhd', p[..., nw:], v_ctx))

    out = lax.map(row_block, jnp.arange(rows))
    return jnp.moveaxis(out, 0, 1).reshape(b, n, nh, hd)


def even_mixer(h_lat, h_ctx, row, col, w_in, conv_w, conv_b, a_log, dt_bias, d_skip, ssm_norm_g,
               lam_q1, lam_k1, lam_q2, lam_k2, subln_g, w_out, lambda_init, with_ctx_out):
    b = h_lat.shape[0]
    s0 = D_SSM
    s1 = s0 + D_XBC
    s2 = s1 + SSM_HEADS
    s3 = s2 + SSM_HEADS
    s4 = s3 + D_QK_DIFF
    s5 = s4 + D_QK_DIFF
    splits = [s0, s1, s2, s3, s4, s5]
    z_l, xbc_l, dtf_l, dtb_l, q_l, k_l, v_l = jnp.split(h_lat @ w_in, splits, axis=-1)
    z_c, xbc_c, dtf_c, dtb_c, q_c, k_c, v_c = jnp.split(h_ctx @ w_in, splits, axis=-1)

    decay = -jnp.exp(a_log)

    def ssd_prep(xbc, dtf, dtb):
        n = xbc.shape[1]
        xbc = jax.nn.silu(depthwise_conv_centred(xbc, conv_w, conv_b))
        xs, bm, cm = jnp.split(xbc, [D_SSM, D_SSM + SSM_GROUPS * SSM_STATE], axis=-1)
        return (xs.reshape(b, n, SSM_HEADS, SSM_HEAD_DIM),
                jax.nn.softplus(dtf + dt_bias[0]), jax.nn.softplus(dtb + dt_bias[1]),
                bm.reshape(b, n, SSM_GROUPS, SSM_STATE), cm.reshape(b, n, SSM_GROUPS, SSM_STATE))

    def ssd_finish(y, xs, z):
        n = y.shape[1]
        y = (y + d_skip[:, None] * xs).reshape(b, n, D_SSM) * jax.nn.silu(z)
        y = rms_norm(y.reshape(b, n, SSM_GROUPS, D_SSM // SSM_GROUPS), ssm_norm_g.reshape(SSM_GROUPS, -1))
        return y.reshape(b, n, D_SSM)

    xs_c, dtf_c, dtb_c, bm_c, cm_c = ssd_prep(xbc_c, dtf_c, dtb_c)
    h0 = jnp.zeros((b, SSM_HEADS, SSM_HEAD_DIM, SSM_STATE), xs_c.dtype)
    y_c, hf_c, hb_c = ssd_bidirectional(xs_c, dtf_c, dtb_c, decay[0], decay[1], bm_c, cm_c, h0, h0)
    xs_l, dtf_l, dtb_l, bm_l, cm_l = ssd_prep(xbc_l, dtf_l, dtb_l)
    y_l, _, _ = ssd_bidirectional(xs_l, dtf_l, dtb_l, decay[0], decay[1], bm_l, cm_l, hf_c, hb_c)

    lam = (jnp.exp(jnp.sum(lam_q1.astype(jnp.float32) * lam_k1.astype(jnp.float32)))
           - jnp.exp(jnp.sum(lam_q2.astype(jnp.float32) * lam_k2.astype(jnp.float32))) + lambda_init)
    qk_heads = lambda t: t.reshape(t.shape[0], t.shape[1], 2 * DIFF_HEADS, DIFF_HEAD_DIM)
    v_heads = lambda t: t.reshape(t.shape[0], t.shape[1], DIFF_HEADS, 2 * DIFF_HEAD_DIM)
    kd_c, vd_c = qk_heads(k_c), v_heads(v_c)
    k_all = jnp.concatenate([kd_c, axial_rope(qk_heads(k_l), row, col)], axis=1)
    v_all = jnp.concatenate([vd_c, v_heads(v_l)], axis=1)
    o_l = blocked_queries(lambda qb: diff_attend(qb, k_all, v_all, lam), axial_rope(qk_heads(q_l), row, col))

    def diff_finish(o):
        return (rms_norm(o, subln_g) * (1.0 - lambda_init)).reshape(o.shape[0], o.shape[1], D_V_DIFF)

    out_lat = jnp.concatenate([ssd_finish(y_l, xs_l, z_l), diff_finish(o_l)], axis=-1) @ w_out
    if not with_ctx_out:
        return out_lat, None
    o_c = diff_attend(qk_heads(q_c), kd_c, vd_c, lam)
    out_ctx = jnp.concatenate([ssd_finish(y_c, xs_c, z_c), diff_finish(o_c)], axis=-1) @ w_out
    return out_lat, out_ctx


def odd_mixer(h_lat, h_ctx, w_in, rpb, w_out, with_ctx_out):
    b, n_lat = h_lat.shape[:2]
    n_ctx = h_ctx.shape[1]
    heads = lambda t: t.reshape(t.shape[0], t.shape[1], NA_HEADS, NA_HEAD_DIM)
    q_l, k_l, v_l = [heads(t) for t in jnp.split(h_lat @ w_in, 3, axis=-1)]
    k_c, v_c = [heads(t) for t in jnp.split(h_ctx @ w_in[:, D_NA:], 2, axis=-1)]
    out_lat = neighbourhood_attention(q_l, k_l, v_l, k_c, v_c, rpb).reshape(b, n_lat, D_NA) @ w_out
    if not with_ctx_out:
        return out_lat, None
    q_c = heads(h_ctx @ w_in[:, :D_NA])
    out_ctx = softmax_attention(q_c, k_c, v_c).reshape(b, n_ctx, D_NA) @ w_out
    return out_lat, out_ctx


def setup_inputs(seed: int = 0) -> dict:
    key = jax.random.key(seed)
    keys = iter(jax.random.split(key, 40))

    def normal(shape, scale):
        return scale * jax.random.normal(next(keys), shape, dtype=jnp.float32)

    def gain(shape):
        return 1.0 + normal(shape, 0.02)

    d = D_MODEL
    a_init = jax.random.uniform(next(keys), (N_EVEN, 2, SSM_HEADS), jnp.float32, 1.0, 16.0)
    dt0 = jnp.exp(jax.random.uniform(next(keys), (N_EVEN, 2, SSM_HEADS), jnp.float32,
                                     math.log(1e-3), math.log(1e-1)))
    return {
        'x': normal((BATCH, SEQ, d), 1.0),
        'c': normal((BATCH, d), 1.0),
        'ctx': normal((BATCH, CTX_LEN, d), 1.0),
        'c_ctx': normal((d,), 1.0),
        'ada_w': normal((DEPTH, d, 6 * d), 0.5 * d ** -0.5),
        'ada_b': normal((DEPTH, 6 * d), 0.02),
        'norm_mix_g': gain((DEPTH, d)),
        'norm_ffn_g': gain((DEPTH, d)),
        'final_norm_g': gain((d,)),
        'ffn_w1': normal((DEPTH, d, D_FF), d ** -0.5),
        'ffn_w3': normal((DEPTH, d, D_FF), d ** -0.5),
        'ffn_w2': normal((DEPTH, D_FF, d), D_FF ** -0.5),
        'ev_w_in': normal((N_EVEN, d, IN_EVEN), d ** -0.5),
        'ev_conv_w': normal((N_EVEN, SSM_CONV, D_XBC), SSM_CONV ** -0.5),
        'ev_conv_b': normal((N_EVEN, D_XBC), 0.02),
        'ev_a_log': jnp.log(a_init),
        'ev_dt_bias': dt0 + jnp.log(-jnp.expm1(-dt0)),
        'ev_d_skip': 1.0 + normal((N_EVEN, SSM_HEADS), 0.1),
        'ev_ssm_norm_g': gain((N_EVEN, D_SSM)),
        'ev_lam_q1': normal((N_EVEN, DIFF_HEAD_DIM), 0.1),
        'ev_lam_k1': normal((N_EVEN, DIFF_HEAD_DIM), 0.1),
        'ev_lam_q2': normal((N_EVEN, DIFF_HEAD_DIM), 0.1),
        'ev_lam_k2': normal((N_EVEN, DIFF_HEAD_DIM), 0.1),
        'ev_subln_g': gain((N_EVEN, 2 * DIFF_HEAD_DIM)),
        'ev_w_out': normal((N_EVEN, D_MIX_EVEN, d), D_MIX_EVEN ** -0.5),
        'od_w_in': normal((N_ODD, d, 3 * D_NA), d ** -0.5),
        'od_rpb': normal((N_ODD, NA_HEADS, 2 * WIN_ROWS - 1, 2 * WIN_COLS - 1), 0.1),
        'od_w_out': normal((N_ODD, D_NA, d), D_NA ** -0.5),
    }


def reference(x, c, ctx, c_ctx, ada_w, ada_b, norm_mix_g, norm_ffn_g, final_norm_g,
              ffn_w1, ffn_w3, ffn_w2, ev_w_in, ev_conv_w, ev_conv_b, ev_a_log, ev_dt_bias,
              ev_d_skip, ev_ssm_norm_g, ev_lam_q1, ev_lam_k1, ev_lam_q2, ev_lam_k2, ev_subln_g,
              ev_w_out, od_w_in, od_rpb, od_w_out):
    n_tok = x.shape[1]
    pos = jnp.arange(n_tok)
    row, col = pos // GRID_W, pos % GRID_W
    cond_lat = jax.nn.silu(c)
    cond_ctx = jax.nn.silu(c_ctx)
    for i in range(DEPTH):
        ctx_out = i < DEPTH - 1
        sh1, sc1, g1, sh2, sc2, g2 = jnp.split((cond_lat @ ada_w[i] + ada_b[i])[:, None, :], 6, axis=-1)
        csh1, csc1, cg1, csh2, csc2, cg2 = jnp.split(cond_ctx @ ada_w[i] + ada_b[i], 6, axis=-1)
        h_lat = modulate(rms_norm(x, norm_mix_g[i]), sh1, sc1)
        h_ctx = modulate(rms_norm(ctx, norm_mix_g[i]), csh1, csc1)
        j = i // 2
        if i % 2 == 0:
            lambda_init = 0.8 - 0.6 * math.exp(-0.3 * i)
            o_lat, o_ctx = even_mixer(h_lat, h_ctx, row, col, ev_w_in[j], ev_conv_w[j], ev_conv_b[j],
                                      ev_a_log[j], ev_dt_bias[j], ev_d_skip[j], ev_ssm_norm_g[j],
                                      ev_lam_q1[j], ev_lam_k1[j], ev_lam_q2[j], ev_lam_k2[j],
                                      ev_subln_g[j], ev_w_out[j], lambda_init, ctx_out)
        else:
            o_lat, o_ctx = odd_mixer(h_lat, h_ctx, od_w_in[j], od_rpb[j], od_w_out[j], ctx_out)
        x = x + g1 * o_lat
        x = x + g2 * swiglu(modulate(rms_norm(x, norm_ffn_g[i]), sh2, sc2), ffn_w1[i], ffn_w3[i], ffn_w2[i])
        if ctx_out:
            ctx = ctx + cg1 * o_ctx
            ctx = ctx + cg2 * swiglu(modulate(rms_norm(ctx, norm_ffn_g[i]), csh2, csc2),
                                     ffn_w1[i], ffn_w3[i], ffn_w2[i])
    return rms_norm(x, final_norm_g)
```

```cpp
#include <hip/hip_runtime.h>
#include <hip/hip_cooperative_groups.h>
#include <cstdio>
#include <cstdint>
namespace cg = cooperative_groups;
namespace pg8 {
#define PG8_LAS __attribute__((address_space(3)))
typedef unsigned short bf16_t;
typedef short bf16x8 __attribute__((ext_vector_type(8)));
typedef float f32x4 __attribute__((ext_vector_type(4)));
typedef unsigned u32x4 __attribute__((ext_vector_type(4)));
constexpr int BM = 256, BK = 64, HALF = 128, HTB = HALF * BK * 2  , STAGE_BYTES = 8 * HTB, NXCD = 8, WGM = 8;

__host__ __device__ __forceinline__ int lds_byte(int r, int c) { const int st = (r >> 4) * 2 + (c >> 5), rr = r & 15, cc = c & 31, ob = rr * 64 + cc * 2; return st * 1024 + (ob ^ (((ob >> 9) & 1) << 5)); }
__host__ __device__ __forceinline__ void stage_rc(int b, int& R, int& C) { const int st = b / 1024, sb = b % 1024, swz = sb ^ (((sb >> 9) & 1) << 5); R = (st >> 1) * 16 + swz / 64; C = (st & 1) * 32 + (swz % 64) / 2; }
__host__ __device__ __forceinline__ int perm32(int rho) { const int n = rho >> 4, i = rho & 15; return 8 * (i >> 2) + 4 * n + (i & 3); }

struct Unit { int pm, pn; };
struct Gemm { const bf16_t* A; const bf16_t* Bt; int M, N, K; };

struct StaticOrder {
    int nM, nN, nwg, G, c;
    __host__ __device__ void init(int M, int N, int G_, int c_) { nM = M / BM; nN = N / BM; nwg = nM * nN; G = G_; c = c_; }
    __host__ __device__ bool next(int i, Unit& u) const {
        const long L = (long)i * G + c; if (L >= nwg) return false;
        int wgid = (int)L; { const int q = nwg / NXCD, r = nwg % NXCD, xcd = wgid % NXCD, off = wgid / NXCD; wgid = (xcd < r ? xcd * (q + 1) : r * (q + 1) + (xcd - r) * q) + off; }
        const int nig = WGM * nN, gid = wgid / nig, fm = gid * WGM, gsz = (nM - fm) < WGM ? (nM - fm) : WGM;
        u.pm = fm + ((wgid % nig) % gsz); u.pn = (wgid % nig) / gsz; return true;
    }
    __device__ __forceinline__ void a_ready(const Unit&) const {}
    __device__ __forceinline__ void done(const Unit&) const {}
};
__device__ __forceinline__ unsigned cvt_pk_bf16(float lo, float hi) { unsigned r; asm volatile("v_cvt_pk_bf16_f32 %0, %1, %2" : "=v"(r) : "v"(lo), "v"(hi)); return r; }
typedef float f32x2 __attribute__((ext_vector_type(2)));
__device__ __forceinline__ f32x2 gelu_pk(f32x2 v) {
    const f32x2 av = __builtin_elementwise_abs(v), d = av * 0.2316418882f + 1.0f;
    f32x2 t; t.x = __builtin_amdgcn_rcpf(d.x); t.y = __builtin_amdgcn_rcpf(d.y);
    f32x2 q = t * 0.5307027145f + (-0.7265760135f); q = q * t + 0.7107068705f; q = q * t + (-0.142248368f); q = q * t + 0.127414796f; q = q * t;
    const f32x2 s = (v * v) * (-0.72134752044f);
    f32x2 e; e.x = __builtin_amdgcn_exp2f(s.x); e.y = __builtin_amdgcn_exp2f(s.y);
    const f32x2 m = v * (q * e), r = v - m;
    f32x2 o; o.x = v.x < 0.f ? m.x : r.x; o.y = v.y < 0.f ? m.y : r.y; return o;
}

struct EpiF32 {
    static constexpr bool PERM = false, AFTER_DRAIN = false;
    float* C; int ldc; const float* bias;
    __device__ __forceinline__ void operator()(const f32x4 (&acc)[2][2][4][2], const Unit& u, int wr, int wc, int fr, int fq) const {
        const int row0 = u.pm * BM + wr * 64 + fr, col0 = u.pn * BM + wc * 32 + 4 * fq;
        f32x4 bv[2][2];
#pragma unroll
        for (int bj = 0; bj < 2; ++bj)
#pragma unroll
            for (int n = 0; n < 2; ++n) bv[bj][n] = bias ? *(const f32x4*)(bias + col0 + bj * HALF + n * 16) : (f32x4){0.f, 0.f, 0.f, 0.f};
#pragma unroll
        for (int ai = 0; ai < 2; ++ai)
#pragma unroll
            for (int m = 0; m < 4; ++m) { float* rowp = C + (size_t)(row0 + ai * HALF + m * 16) * ldc + col0;
#pragma unroll
                for (int bj = 0; bj < 2; ++bj)
#pragma unroll
                    for (int n = 0; n < 2; ++n) *(f32x4*)(rowp + bj * HALF + n * 16) = acc[ai][bj][m][n] + bv[bj][n]; }
    }
};
template <int ACT  > struct EpiBf16 {
    static constexpr bool PERM = true, AFTER_DRAIN = false;
    bf16_t* O; int ldc; const float* bias; int split_cols; size_t split_stride;
    __device__ __forceinline__ void operator()(const f32x4 (&acc)[2][2][4][2], const Unit& u, int wr, int wc, int fr, int fq) const {
        const int row0 = u.pm * BM + wr * 64 + fr; int colt = u.pn * BM; bf16_t* base = O;
        if (split_cols) { const int t = colt / split_cols; base += (size_t)t * split_stride; colt -= t * split_cols; }
        const int col0 = colt + wc * 32 + 8 * fq, bcol0 = u.pn * BM + wc * 32 + 8 * fq;
        f32x4 bv[2][2];
#pragma unroll
        for (int bj = 0; bj < 2; ++bj)
#pragma unroll
            for (int n = 0; n < 2; ++n) bv[bj][n] = bias ? *(const f32x4*)(bias + bcol0 + bj * HALF + 4 * n) : (f32x4){0.f, 0.f, 0.f, 0.f};
#pragma unroll
        for (int ai = 0; ai < 2; ++ai)
#pragma unroll
            for (int m = 0; m < 4; ++m) { bf16_t* rowp = base + (size_t)(row0 + ai * HALF + m * 16) * ldc + col0;
#pragma unroll
                for (int bj = 0; bj < 2; ++bj) { f32x4 v0 = acc[ai][bj][m][0] + bv[bj][0], v1 = acc[ai][bj][m][1] + bv[bj][1];
                    if (ACT == 1) { f32x2 a = gelu_pk((f32x2){v0[0], v0[1]}), b = gelu_pk((f32x2){v0[2], v0[3]}), c = gelu_pk((f32x2){v1[0], v1[1]}), d = gelu_pk((f32x2){v1[2], v1[3]});
                        v0 = (f32x4){a.x, a.y, b.x, b.y}; v1 = (f32x4){c.x, c.y, d.x, d.y}; }
                    if (ACT == 2) {
#pragma unroll
                        for (int j = 0; j < 4; ++j) { v0[j] = 0.5f * v0[j] * (1.0f + erff(v0[j] * 0.70710678f)); v1[j] = 0.5f * v1[j] * (1.0f + erff(v1[j] * 0.70710678f)); } }
                    u32x4 w; w.x = cvt_pk_bf16(v0[0], v0[1]); w.y = cvt_pk_bf16(v0[2], v0[3]); w.z = cvt_pk_bf16(v1[0], v1[1]); w.w = cvt_pk_bf16(v1[2], v1[3]);
                    *(u32x4*)(rowp + bj * HALF) = w; } }
    }
};

template <class Epi, class Sched, bool STAMP = false>
__device__ __forceinline__ void gemm_phase(PG8_LAS unsigned char* lds, const Gemm g, const Sched& S, const Epi& E, unsigned long long* stamps) {
    const int tid = threadIdx.x, wid = __builtin_amdgcn_readfirstlane(tid >> 6), lane = tid & 63, wr = wid >> 2, wc = wid & 3, fr = lane & 15, fq = lane >> 4;
    const int K = g.K, nt = K / BK;
    int ts_lo = 0, ts_hi = 0, nts = 0; const unsigned long long rt_entry = STAMP ? (unsigned long long)wall_clock64() : 0ull;
#define PG8_STAMP() do { if (STAMP && wid == 0 && nts < 64) { const unsigned long long _c = (unsigned long long)clock64(); \
        ts_lo = (lane == nts) ? (int)(unsigned)_c : ts_lo; ts_hi = (lane == nts) ? (int)(unsigned)(_c >> 32) : ts_hi; ++nts; } } while (0)
    PG8_STAMP();
    unsigned voffA[2], voffB[2];
#pragma unroll
    for (int i = 0; i < 2; ++i) { int R, C; stage_rc(tid * 16 + i * 8192, R, C); const int Rb = Epi::PERM ? ((R & ~31) + perm32(R & 31)) : R;
        voffA[i] = (unsigned)(R * K + C) * 2u; voffB[i] = (unsigned)(Rb * K + C) * 2u; }
    const size_t kstep = (size_t)(BK * 2);
    const size_t hstep = (size_t)HALF * K * 2;
    const size_t tstep = 2 * hstep;
    const unsigned ldsw = (unsigned)wid * 1024u;
    const int aoff = lds_byte(wr * 64 + fr, fq * 8), boff = lds_byte(wc * 32 + fr, fq * 8);
#define PG8_SA(b, h) (((b) * 2 + (h)) * HTB)
#define PG8_SB(b, h) ((4 + (b) * 2 + (h)) * HTB)
#define PG8_STAGE(bufoff, gbase, voff) do { _Pragma("unroll") for (int _i = 0; _i < 2; ++_i) \
        __builtin_amdgcn_global_load_lds((const unsigned*)((const char*)(gbase) + (voff)[_i]), (PG8_LAS unsigned*)(lds + (bufoff) + ldsw + _i * 8192), 16, 0, 0); } while (0)
#define PG8_LDA(dst, b, h) do { _Pragma("unroll") for (int m = 0; m < 4; ++m) _Pragma("unroll") for (int k = 0; k < 2; ++k) dst[m][k] = *(const PG8_LAS bf16x8*)(lds + PG8_SA(b, h) + aoff + m * 2048 + k * 1024); } while (0)
#define PG8_LDB(dst, b, h) do { _Pragma("unroll") for (int n = 0; n < 2; ++n) _Pragma("unroll") for (int k = 0; k < 2; ++k) dst[n][k] = *(const PG8_LAS bf16x8*)(lds + PG8_SB(b, h) + boff + n * 2048 + k * 1024); } while (0)
#define PG8_MMA(ai, bj, At, Bt) do { __builtin_amdgcn_s_setprio(1); _Pragma("unroll") for (int m = 0; m < 4; ++m) _Pragma("unroll") for (int n = 0; n < 2; ++n) _Pragma("unroll") for (int k = 0; k < 2; ++k) \
        acc[ai][bj][m][n] = __builtin_amdgcn_mfma_f32_16x16x32_bf16(Bt[n][k], At[m][k], acc[ai][bj][m][n], 0, 0, 0); __builtin_amdgcn_s_setprio(0); } while (0)
#define PG8_WAIT_V(n) asm volatile("s_waitcnt vmcnt(" #n ")" ::: "memory")
#define PG8_WAIT_L(n) asm volatile("s_waitcnt lgkmcnt(" #n ")" ::: "memory")
#define PG8_BAR __builtin_amdgcn_s_barrier()
#define PG8_SCHED __builtin_amdgcn_sched_barrier(0)
    Unit cur, nxt; int ui = 0;
    if (!S.next(0, cur)) return;
    f32x4 acc[2][2][4][2];
#pragma unroll
    for (int a = 0; a < 2; ++a)
#pragma unroll
        for (int b = 0; b < 2; ++b)
#pragma unroll
            for (int m = 0; m < 4; ++m)
#pragma unroll
                for (int n = 0; n < 2; ++n) acc[a][b][m][n] = (f32x4){0.f, 0.f, 0.f, 0.f};
    bf16x8 At[4][2], B0[2][2], B1[2][2];
    const char* cA = (const char*)g.A + (size_t)cur.pm * tstep; const char* cB = (const char*)g.Bt + (size_t)cur.pn * tstep;
    S.a_ready(cur);
    PG8_STAGE(PG8_SB(0, 0), cB, voffB); PG8_STAGE(PG8_SA(0, 0), cA, voffA); PG8_STAGE(PG8_SB(0, 1), cB + hstep, voffB); PG8_STAGE(PG8_SA(0, 1), cA + hstep, voffA);
    if (wr == 1) PG8_BAR;
    PG8_WAIT_V(4); PG8_BAR;
    PG8_STAGE(PG8_SB(1, 0), cB + kstep, voffB); PG8_STAGE(PG8_SA(1, 0), cA + kstep, voffA); PG8_STAGE(PG8_SB(1, 1), cB + hstep + kstep, voffB);
    PG8_WAIT_V(6); PG8_BAR;
    PG8_STAMP();
    for (;;) {
        const bool has_next = S.next(ui + 1, nxt);
        const char* nA = has_next ? (const char*)g.A + (size_t)nxt.pm * tstep : cA; const char* nB = has_next ? (const char*)g.Bt + (size_t)nxt.pn * tstep : cB;
        for (int t = 0; t < nt; t += 2) {
            const bool last = (t == nt - 2);
            const char* a1 = cA + (size_t)(t + 1) * kstep;
            const char* a2 = last ? nA : cA + (size_t)(t + 2) * kstep; const char* b2 = last ? nB : cB + (size_t)(t + 2) * kstep;
            const char* a3 = a2 + kstep; const char* b3 = b2 + kstep;
            if (last && has_next) S.a_ready(nxt);
            PG8_LDB(B0, 0, 0); PG8_SCHED; PG8_LDA(At, 0, 0); PG8_STAGE(PG8_SA(1, 1), a1 + hstep, voffA);
            PG8_WAIT_L(8); PG8_BAR; PG8_WAIT_L(0); PG8_MMA(0, 0, At, B0); PG8_BAR; PG8_SCHED;
            PG8_LDB(B1, 0, 1); PG8_STAGE(PG8_SB(0, 0), b2, voffB);
            PG8_BAR; PG8_WAIT_L(0); PG8_MMA(0, 1, At, B1); PG8_BAR;
            PG8_LDA(At, 0, 1); PG8_STAGE(PG8_SA(0, 0), a2, voffA);
            PG8_BAR; PG8_WAIT_L(0); PG8_MMA(1, 0, At, B0); PG8_BAR; PG8_SCHED;
            PG8_STAGE(PG8_SB(0, 1), b2 + hstep, voffB);
            PG8_WAIT_V(6); PG8_BAR; PG8_MMA(1, 1, At, B1); PG8_BAR;
            PG8_LDB(B0, 1, 0); PG8_SCHED; PG8_LDA(At, 1, 0); PG8_STAGE(PG8_SA(0, 1), a2 + hstep, voffA);
            PG8_WAIT_L(8); PG8_BAR; PG8_WAIT_L(0); PG8_MMA(0, 0, At, B0); PG8_BAR; PG8_SCHED;
            PG8_LDB(B1, 1, 1); PG8_STAGE(PG8_SB(1, 0), b3, voffB);
            PG8_BAR; PG8_WAIT_L(0); PG8_MMA(0, 1, At, B1); PG8_BAR;
            PG8_LDA(At, 1, 1); PG8_STAGE(PG8_SA(1, 0), a3, voffA);
            PG8_BAR; PG8_WAIT_L(0); PG8_MMA(1, 0, At, B0); PG8_BAR; PG8_SCHED;
            PG8_STAGE(PG8_SB(1, 1), b3 + hstep, voffB);
            PG8_WAIT_V(6); PG8_BAR; PG8_MMA(1, 1, At, B1); PG8_BAR;
        }
        PG8_STAMP();
        if constexpr (!Epi::AFTER_DRAIN) { E(acc, cur, wr, wc, fr, fq); S.done(cur); }
        PG8_STAMP();
        if (!has_next) break;
#pragma unroll
        for (int a = 0; a < 2; ++a)
#pragma unroll
            for (int b = 0; b < 2; ++b)
#pragma unroll
                for (int m = 0; m < 4; ++m)
#pragma unroll
                    for (int n = 0; n < 2; ++n) acc[a][b][m][n] = (f32x4){0.f, 0.f, 0.f, 0.f};
        cur = nxt; cA = nA; cB = nB; ++ui;
    }
    PG8_WAIT_V(0);
    if (wr == 0) PG8_BAR;
    PG8_BAR;
    if constexpr (Epi::AFTER_DRAIN) { E.fused(acc, cur, wr, wc, fr, fq, lds, wid, lane); S.done(cur); }
    PG8_STAMP();
    if (STAMP && wid == 0) { stamps[lane] = lane < nts ? (((unsigned long long)(unsigned)ts_hi << 32) | (unsigned)ts_lo) : 0ull;
        if (lane == 62) stamps[62] = rt_entry; if (lane == 63) stamps[63] = (unsigned long long)wall_clock64(); }
#undef PG8_STAMP
#undef PG8_SA
#undef PG8_SB
#undef PG8_STAGE
#undef PG8_LDA
#undef PG8_LDB
#undef PG8_MMA
#undef PG8_WAIT_V
#undef PG8_WAIT_L
#undef PG8_BAR
#undef PG8_SCHED
}
}
#define DI __device__ __forceinline__
#define LAS __attribute__((address_space(3)))
typedef unsigned short bf16;
typedef short bf16x8 __attribute__((ext_vector_type(8)));
typedef short bf16x4 __attribute__((ext_vector_type(4)));
typedef float f32x4 __attribute__((ext_vector_type(4)));
typedef unsigned u32x4 __attribute__((ext_vector_type(4)));
typedef unsigned u32x2 __attribute__((ext_vector_type(2)));

constexpr int DM = 2048, MROWS = 9216, CROWS = 1024, DFF = 5632, NIN0 = 6400, NIN1 = 6144, ZXP = 6400;
constexpr float EPS = 1e-6f, LOG2E = 1.4426950408889634f;
constexpr size_t MiB = 1u << 20;
constexpr size_t WS_WIN0 = 0, WS_WOUT0 = 25 * MiB, WS_WUP0 = 33 * MiB, WS_WDN0 = 77 * MiB, WS_WIN1 = 99 * MiB, WS_WOUT1 = 123 * MiB, WS_WUP1 = 131 * MiB, WS_WDN1 = 175 * MiB;
constexpr size_t WS_MOD = 197 * MiB, WS_XRES = 198 * MiB  , WS_H = 270 * MiB, WS_MIX = 306 * MiB, WS_BIG = 342 * MiB  ;
constexpr size_t WS_XBC = 567 * MiB, WS_QK = 603 * MiB, WS_V = 639 * MiB, WS_DT = 657 * MiB, WS_ACUM = 659 * MiB, WS_DEC = 661 * MiB, WS_HIN = 662 * MiB, WS_USCR = 698 * MiB  , WS_END = 762 * MiB;
constexpr int LDS_BYTES = 147456;

struct Args { const float* in[28]; float* out; unsigned char* ws; };
typedef const float* fptr_t;
__device__ __forceinline__ const float* inp(int i) { const volatile __attribute__((address_space(4))) fptr_t* kp = (const volatile __attribute__((address_space(4))) fptr_t*)__builtin_amdgcn_kernarg_segment_ptr(); return kp[i]; }

DI unsigned f2bf(float f) { unsigned u = __float_as_uint(f); return (u + 0x7fffu + ((u >> 16) & 1u)) >> 16; }
DI unsigned pk2(float lo, float hi) { return f2bf(lo) | (f2bf(hi) << 16); }
DI float bf2f(unsigned short b) { return __uint_as_float(((unsigned)b) << 16); }
DI float wave_sum(float v) {
#pragma unroll
    for (int o = 1; o < 64; o <<= 1) v += __shfl_xor(v, o);
    return v; }
DI float silu_f(float v) { return v / (1.f + expf(-v)); }
DI f32x4 mfma16(bf16x8 a, bf16x8 b, f32x4 c) { return __builtin_amdgcn_mfma_f32_16x16x32_bf16(a, b, c, 0, 0, 0); }
DI int row_batch(int row) { return row < CROWS ? 4 : (row - CROWS) >> 11; }
DI int chunk_row(int b, int c) { return c < 2 ? b * 256 + c * 128 : CROWS + b * 2048 + (c - 2) * 128; }

template <int R, int C> DI void stage_N(LAS bf16* dst, int dp, const bf16* src, size_t gp, int tid) {
#pragma unroll
    for (int ch = tid; ch < R * C / 8; ch += 512) { const int r = ch / (C / 8), c8 = ch % (C / 8);
        *(LAS u32x4*)(dst + r * dp + c8 * 8) = *(const u32x4*)(src + (size_t)r * gp + c8 * 8); }
}
template <int R, int C> DI void stage_T(LAS bf16* dst, int dp, const bf16* src, size_t gp, int tid) {
#pragma unroll
    for (int ch = tid; ch < R * C / 8; ch += 512) { const int r = ch % R, c8 = ch / R;
        const u32x4 v = *(const u32x4*)(src + (size_t)r * gp + c8 * 8);
        LAS bf16* d = dst + (c8 * 8) * dp + r;
        d[0] = (bf16)(v.x & 0xffffu); d[dp] = (bf16)(v.x >> 16); d[2 * dp] = (bf16)(v.y & 0xffffu); d[3 * dp] = (bf16)(v.y >> 16);
        d[4 * dp] = (bf16)(v.z & 0xffffu); d[5 * dp] = (bf16)(v.z >> 16); d[6 * dp] = (bf16)(v.w & 0xffffu); d[7 * dp] = (bf16)(v.w >> 16); }
}
DI bf16x8 lds_frag16(const LAS bf16* p) { return *(const LAS bf16x8*)p; }
DI bf16x8 lds_frag8x2(const LAS bf16* p0, const LAS bf16* p1) { const bf16x4 a = *(const LAS bf16x4*)p0, b = *(const LAS bf16x4*)p1; return __builtin_shufflevector(a, b, 0, 1, 2, 3, 4, 5, 6, 7); }
DI bf16x8 pack8(const f32x4 a, const f32x4 b) { u32x4 w; w.x = pk2(a[0], a[1]); w.y = pk2(a[2], a[3]); w.z = pk2(b[0], b[1]); w.w = pk2(b[2], b[3]); return __builtin_bit_cast(bf16x8, w); }

struct EpiResid {
    static constexpr bool PERM = false, AFTER_DRAIN = false;
    const float* resA; const float* resB; const float* mod; int goff; float* out; int row_base;
    __device__ __forceinline__ void operator()(const pg8::f32x4 (&acc)[2][2][4][2], const pg8::Unit& u, int wr, int wc, int fr, int fq) const {
        const int rowt = row_base + u.pm * 256; const int brow = row_batch(rowt);
        const int row0 = rowt + wr * 64 + fr, col0 = u.pn * 256 + wc * 32 + 4 * fq;
        const float* gp = mod + (size_t)brow * 12288 + goff + col0;
        f32x4 gv[2][2];
#pragma unroll
        for (int bj = 0; bj < 2; ++bj)
#pragma unroll
            for (int n = 0; n < 2; ++n) gv[bj][n] = *(const f32x4*)(gp + bj * 128 + n * 16);
#pragma unroll
        for (int ai = 0; ai < 2; ++ai)
#pragma unroll
            for (int m = 0; m < 4; ++m) { const int row = row0 + ai * 128 + m * 16;
                const float* rp = (row < CROWS ? resA + (size_t)row * DM : resB + (size_t)(row - CROWS) * DM) + col0; float* op = out + (size_t)row * DM + col0;
#pragma unroll
                for (int bj = 0; bj < 2; ++bj)
#pragma unroll
                    for (int n = 0; n < 2; ++n) { const f32x4 rv = *(const f32x4*)(rp + bj * 128 + n * 16); *(f32x4*)(op + bj * 128 + n * 16) = rv + gv[bj][n] * acc[ai][bj][m][n]; } }
    }
};
struct EpiSwiGLU {
    static constexpr bool PERM = true, AFTER_DRAIN = false;
    bf16* O; int row_base;
    __device__ __forceinline__ void operator()(const pg8::f32x4 (&acc)[2][2][4][2], const pg8::Unit& u, int wr, int wc, int fr, int fq) const {
        const int row0 = row_base + u.pm * 256 + wr * 64 + fr, col0 = u.pn * 128 + wc * 32 + 8 * fq;
#pragma unroll
        for (int ai = 0; ai < 2; ++ai)
#pragma unroll
            for (int m = 0; m < 4; ++m) { bf16* op = O + (size_t)(row0 + ai * 128 + m * 16) * DFF + col0;
                f32x4 v0, v1;
#pragma unroll
                for (int j = 0; j < 4; ++j) { const float a0 = acc[ai][0][m][0][j], a1 = acc[ai][0][m][1][j]; v0[j] = a0 / (1.f + __expf(-a0)) * acc[ai][1][m][0][j]; v1[j] = a1 / (1.f + __expf(-a1)) * acc[ai][1][m][1][j]; }
                u32x4 w; w.x = pk2(v0[0], v0[1]); w.y = pk2(v0[2], v0[3]); w.z = pk2(v1[0], v1[1]); w.w = pk2(v1[2], v1[3]);
                *(u32x4*)op = w; }
    }
};
struct Ctx { LAS unsigned char* lds; int tid, lane, wave, q, l15, gw, ngw; unsigned char* ws; };

DI void tr_item(const float* W, int K, int N, bf16* WT, int mode, LAS float* scr, int item, int lane) {
    const int nblk = N / 32, kb = item / nblk, nb = item % nblk, k0 = 64 * kb, n0 = 32 * nb;
#pragma unroll 8
    for (int i = 0; i < 32; ++i) { const int kk = 2 * i + (lane >> 5); scr[kk * 33 + (lane & 31)] = W[(size_t)(k0 + kk) * N + n0 + (lane & 31)]; }
    asm volatile("s_waitcnt lgkmcnt(0)" ::: "memory");
    int d0 = n0;
    if (mode == 1) d0 = n0 < 3072 ? n0 : (n0 < 3104 ? 6144 + (n0 - 3072) : n0 - 32);
    else if (mode == 2) d0 = (n0 / 128) * 256 + (n0 % 128);
    else if (mode == 3) d0 = (n0 / 128) * 256 + 128 + (n0 % 128);
    const int c = lane & 7;
#pragma unroll
    for (int j = 0; j < 4; ++j) { const int n = (lane >> 3) + 8 * j; const LAS float* s = scr + (8 * c) * 33 + n;
        u32x4 o; o.x = pk2(s[0 * 33], s[1 * 33]); o.y = pk2(s[2 * 33], s[3 * 33]); o.z = pk2(s[4 * 33], s[5 * 33]); o.w = pk2(s[6 * 33], s[7 * 33]);
        *(u32x4*)(WT + (size_t)(d0 + n) * K + k0 + 8 * c) = o; }
    asm volatile("s_waitcnt lgkmcnt(0)" ::: "memory");
}
DI void p0_phase(const Args& a, const Ctx& X) {
    unsigned char* const wsl = (unsigned char*)inp(29);
    LAS float* cond = (LAS float*)X.lds;
    LAS float* red = (LAS float*)(X.lds + 40960);
    float* MOD = (float*)(wsl + WS_MOD);
    for (int i = X.tid; i < 5 * 2048; i += 512) { const float v = i < 8192 ? inp(1)[i] : inp(3)[i - 8192]; cond[i] = silu_f(v); }
    __syncthreads();
    for (int it = blockIdx.x; it < 384; it += gridDim.x) {
        const int l = it / 192, n0 = (it % 192) * 64, cq = X.tid & 15, ks = X.tid >> 4;
        const float* W = inp(4) + (size_t)l * 2048 * 12288 + n0 + 4 * cq;
        float acc[5][4];
#pragma unroll
        for (int r = 0; r < 5; ++r)
#pragma unroll
            for (int j = 0; j < 4; ++j) acc[r][j] = 0.f;
#pragma unroll 8
        for (int kk = 0; kk < 64; ++kk) { const int k = ks * 64 + kk; const f32x4 w = *(const f32x4*)(W + (size_t)k * 12288);
#pragma unroll
            for (int r = 0; r < 5; ++r) { const float cv = cond[r * 2048 + k];
#pragma unroll
                for (int j = 0; j < 4; ++j) acc[r][j] += cv * w[j]; } }
#pragma unroll
        for (int r = 0; r < 5; ++r)
#pragma unroll
            for (int j = 0; j < 4; ++j) red[X.tid * 20 + r * 4 + j] = acc[r][j];
        __syncthreads();
        for (int o = X.tid; o < 320; o += 512) { const int r = o / 64, cc = o % 64, cq2 = cc >> 2, ci = cc & 3; float s = 0.f;
            for (int k2 = 0; k2 < 32; ++k2) s += red[(k2 * 16 + cq2) * 20 + r * 4 + ci];
            MOD[(size_t)(l * 5 + r) * 12288 + n0 + cc] = s + inp(5)[l * 12288 + n0 + cc]; }
        __syncthreads();
    }
    __syncthreads();
    LAS float* scr = (LAS float*)(X.lds + X.wave * 8448);
    bf16* w = (bf16*)wsl;
    constexpr int I_IN0 = 32 * 193, I_SQ = 32 * 64, I_UP = 32 * 176, I_DN = 88 * 64, I_IN1 = 32 * 192;
    constexpr int NIT = I_IN0 + I_SQ + 2 * I_UP + I_DN + I_IN1 + I_SQ + 2 * I_UP + I_DN;
    for (int it = X.gw; it < NIT; it += X.ngw) {
        int r = it;
        if (r < I_IN0) { tr_item(inp(12), 2048, 6176, (bf16*)(wsl + WS_WIN0), 1, scr, r, X.lane); continue; } r -= I_IN0;
        if (r < I_SQ) { tr_item(inp(24), 2048, 2048, (bf16*)(wsl + WS_WOUT0), 0, scr, r, X.lane); continue; } r -= I_SQ;
        if (r < I_UP) { tr_item(inp(9), 2048, DFF, (bf16*)(wsl + WS_WUP0), 2, scr, r, X.lane); continue; } r -= I_UP;
        if (r < I_UP) { tr_item(inp(10), 2048, DFF, (bf16*)(wsl + WS_WUP0), 3, scr, r, X.lane); continue; } r -= I_UP;
        if (r < I_DN) { tr_item(inp(11), DFF, 2048, (bf16*)(wsl + WS_WDN0), 0, scr, r, X.lane); continue; } r -= I_DN;
        if (r < I_IN1) { tr_item(inp(25), 2048, 6144, (bf16*)(wsl + WS_WIN1), 0, scr, r, X.lane); continue; } r -= I_IN1;
        if (r < I_SQ) { tr_item(inp(27), 2048, 2048, (bf16*)(wsl + WS_WOUT1), 0, scr, r, X.lane); continue; } r -= I_SQ;
        if (r < I_UP) { tr_item(inp(9) + (size_t)2048 * DFF, 2048, DFF, (bf16*)(wsl + WS_WUP1), 2, scr, r, X.lane); continue; } r -= I_UP;
        if (r < I_UP) { tr_item(inp(10) + (size_t)2048 * DFF, 2048, DFF, (bf16*)(wsl + WS_WUP1), 3, scr, r, X.lane); continue; } r -= I_UP;
        tr_item(inp(11) + (size_t)2048 * DFF, DFF, 2048, (bf16*)(wsl + WS_WDN1), 0, scr, r, X.lane);
    }
    { u32x4* z = (u32x4*)(wsl + WS_WIN0 + (size_t)6176 * 2048 * 2); const u32x4 zero = {0u, 0u, 0u, 0u};
      for (int i = blockIdx.x * 512 + X.tid; i < 224 * 2048 * 2 / 16; i += gridDim.x * 512) z[i] = zero; }
    (void)w;
}

DI void norm_mod_phase(const Ctx& X, const float* srcA, const float* srcB, const float* g, const float* mod, int shoff, int scoff, bf16* H, int row_lo, int row_hi) {
    for (int row = row_lo + X.gw; row < row_hi; row += X.ngw) {
        const float* xr = row < CROWS ? srcA + (size_t)row * DM : srcB + (size_t)(row - CROWS) * DM;
        const int brow = row_batch(row); const float* sh = mod + (size_t)brow * 12288 + shoff; const float* sc = mod + (size_t)brow * 12288 + scoff;
        f32x4 v[8]; float s = 0.f;
#pragma unroll
        for (int j = 0; j < 8; ++j) { v[j] = ((const f32x4*)xr)[X.lane + 64 * j]; s += (v[j][0] * v[j][0] + v[j][1] * v[j][1]) + (v[j][2] * v[j][2] + v[j][3] * v[j][3]); }
        s = wave_sum(s); const float rstd = 1.f / sqrtf(s * (1.f / DM) + EPS);
#pragma unroll
        for (int j = 0; j < 8; ++j) { const int c4 = X.lane + 64 * j; const f32x4 gg = ((const f32x4*)g)[c4], sv = ((const f32x4*)sc)[c4], hv = ((const f32x4*)sh)[c4];
            f32x4 o; for (int e = 0; e < 4; ++e) o[e] = v[j][e] * rstd * gg[e] * (1.f + sv[e]) + hv[e];
            u32x2 w; w.x = pk2(o[0], o[1]); w.y = pk2(o[2], o[3]); ((u32x2*)(H + (size_t)row * DM))[c4] = w; }
    }
}

DI void post_phase(const Args& a, const Ctx& X) {
    unsigned char* const wsl = (unsigned char*)inp(29);
    LAS float* cs = (LAS float*)X.lds;
    for (int i = X.tid; i < 1024; i += 512) { const int p = i >> 4, j = i & 15; const float inv = powf(10000.f, -(float)j / 16.f); const float ang = (float)p * inv; cs[i] = cosf(ang); cs[1024 + i] = sinf(ang); }
    __syncthreads();
    const float* ZX = (const float*)(wsl + WS_BIG); bf16* XBC = (bf16*)(wsl + WS_XBC); bf16* QK = (bf16*)(wsl + WS_QK); bf16* V = (bf16*)(wsl + WS_V); float* DT = (float*)(wsl + WS_DT);
    const float* cw = inp(13); const float* cb = inp(14); const float* dtb = inp(16);
    for (int row = X.gw; row < MROWS; row += X.ngw) {
        const bool isctx = row < CROWS; const int t = isctx ? (row & 255) : ((row - CROWS) & 2047); const int seg = isctx ? 256 : 2048;
        const float* zr = ZX + (size_t)row * ZXP;
#pragma unroll
        for (int j = 0; j < 8; ++j) { const int ch = 4 * X.lane + 256 * j; f32x4 acc = *(const f32x4*)(cb + ch);
#pragma unroll
            for (int tap = 0; tap < 5; ++tap) { const int tt = t + tap - 2; if (tt >= 0 && tt < seg) { const f32x4 wv = *(const f32x4*)(cw + tap * 2048 + ch); const f32x4 xv = *(const f32x4*)(zr + (tap - 2) * ZXP + 1024 + ch); acc += wv * xv; } }
            u32x2 w; w.x = pk2(silu_f(acc[0]), silu_f(acc[1])); w.y = pk2(silu_f(acc[2]), silu_f(acc[3])); *(u32x2*)(XBC + (size_t)row * 2048 + ch) = w; }
        if (X.lane < 32) { const float v = zr[6144 + X.lane] + dtb[X.lane]; DT[(size_t)row * 32 + X.lane] = v > 20.f ? v : log1pf(expf(v)); }
        { const int bi = X.lane; const float* src = zr + 3072 + 32 * bi; f32x4 u1[4], u2[4];
#pragma unroll
          for (int j = 0; j < 4; ++j) { u1[j] = *(const f32x4*)(src + 4 * j); u2[j] = *(const f32x4*)(src + 16 + 4 * j); }
          const float scl = bi < 32 ? 0.125f * LOG2E : 1.f;
          const int p = (bi & 1) ? (t & 63) : (t >> 6);
          f32x4 o1[4], o2[4];
#pragma unroll
          for (int j = 0; j < 4; ++j) { f32x4 cv = {1.f, 1.f, 1.f, 1.f}, sv = {0.f, 0.f, 0.f, 0.f};
              if (!isctx) { cv = *(const LAS f32x4*)(cs + p * 16 + 4 * j); sv = *(const LAS f32x4*)(cs + 1024 + p * 16 + 4 * j); }
              o1[j] = (u1[j] * cv - u2[j] * sv) * scl; o2[j] = (u1[j] * sv + u2[j] * cv) * scl; }
          bf16* dst = QK + (size_t)row * 2048 + 32 * bi;
          *(bf16x8*)dst = pack8(o1[0], o1[1]); *(bf16x8*)(dst + 8) = pack8(o1[2], o1[3]); *(bf16x8*)(dst + 16) = pack8(o2[0], o2[1]); *(bf16x8*)(dst + 24) = pack8(o2[2], o2[3]); }
        { const float* src = zr + 5120 + 16 * X.lane; const f32x4 v0 = *(const f32x4*)src, v1 = *(const f32x4*)(src + 4), v2 = *(const f32x4*)(src + 8), v3 = *(const f32x4*)(src + 12);
          bf16* dst = V + (size_t)row * 1024 + 16 * X.lane; *(bf16x8*)dst = pack8(v0, v1); *(bf16x8*)(dst + 8) = pack8(v2, v3); }
    }
}

DI void s1_phase(const Args& a, const Ctx& X) {
    unsigned char* const wsl = (unsigned char*)inp(29);
    LAS bf16* BmT = (LAS bf16*)X.lds; LAS bf16* XT = (LAS bf16*)(X.lds + 34816); LAS float* wgt = (LAS float*)(X.lds + 104448);
    const bf16* XBC = (const bf16*)(wsl + WS_XBC); const float* DT = (const float*)(wsl + WS_DT);
    float* ACUM = (float*)(wsl + WS_ACUM); float* DEC = (float*)(wsl + WS_DEC); float* SST = (float*)(wsl + WS_XRES);
    for (int it = blockIdx.x; it < 288; it += gridDim.x) {
        const int b = it / 72, c = (it >> 2) % 18, g = it & 3, r0 = chunk_row(b, c);
        { const int hh = X.wave & 3, dir = X.wave >> 2, h = 4 * g + hh; const float av = -expf(inp(15)[dir * 16 + h]);
          const float d0 = DT[(size_t)(r0 + 2 * X.lane) * 32 + dir * 16 + h], d1 = DT[(size_t)(r0 + 2 * X.lane + 1) * 32 + dir * 16 + h];
          const float v0 = d0 * av, v1 = d1 * av, ps = v0 + v1; float inc = ps;
#pragma unroll
          for (int o = 1; o < 64; o <<= 1) { const float tv = __shfl_up(inc, o); if (X.lane >= o) inc += tv; }
          const float tot = __shfl(inc, 63), exc = inc - ps;
          float a0, a1; if (dir == 0) { a0 = exc + v0; a1 = inc; } else { a0 = tot - exc; a1 = tot - exc - v0; }
          const size_t idx = ((size_t)((b * 18 + c) * 16 + h)) * 2 + dir;
          ACUM[idx * 128 + 2 * X.lane] = a0; ACUM[idx * 128 + 2 * X.lane + 1] = a1;
          wgt[(hh * 2 + dir) * 128 + 2 * X.lane] = d0 * expf(tot - a0); wgt[(hh * 2 + dir) * 128 + 2 * X.lane + 1] = d1 * expf(tot - a1);
          if (X.lane == 0) DEC[idx] = expf(tot); }
        stage_T<128, 128>(BmT, 136, XBC + (size_t)r0 * 2048 + 1024 + g * 128, 2048, X.tid);
#pragma unroll
        for (int hh = 0; hh < 4; ++hh) stage_T<128, 64>(XT + hh * 64 * 136, 136, XBC + (size_t)r0 * 2048 + (4 * g + hh) * 64, 2048, X.tid);
        __syncthreads();
        bf16x8 bfr[4];
#pragma unroll
        for (int ks = 0; ks < 4; ++ks) bfr[ks] = lds_frag16(BmT + (16 * X.wave + X.l15) * 136 + 32 * ks + 8 * X.q);
#pragma unroll 1
        for (int hd = 0; hd < 8; ++hd) { const int hh = hd >> 1, dir = hd & 1;
            f32x4 acc[4];
#pragma unroll
            for (int pt = 0; pt < 4; ++pt) acc[pt] = (f32x4){0.f, 0.f, 0.f, 0.f};
#pragma unroll
            for (int ks = 0; ks < 4; ++ks) { const LAS float* wp = wgt + hd * 128 + 32 * ks + 8 * X.q; const f32x4 w0 = *(const LAS f32x4*)wp, w1 = *(const LAS f32x4*)(wp + 4);
#pragma unroll
                for (int pt = 0; pt < 4; ++pt) { const bf16x8 xa = lds_frag16(XT + (hh * 64 + 16 * pt + X.l15) * 136 + 32 * ks + 8 * X.q);
                    f32x4 f0, f1;
#pragma unroll
                    for (int j = 0; j < 4; ++j) { f0[j] = bf2f((unsigned short)xa[j]) * w0[j]; f1[j] = bf2f((unsigned short)xa[4 + j]) * w1[j]; }
                    acc[pt] = mfma16(pack8(f0, f1), bfr[ks], acc[pt]); } }
            const size_t idx = ((size_t)((b * 18 + c) * 16 + 4 * g + hh)) * 2 + dir; float* Sp = SST + idx * 8192;
#pragma unroll
            for (int pt = 0; pt < 4; ++pt)
#pragma unroll
                for (int i = 0; i < 4; ++i) Sp[(16 * pt + 4 * X.q + i) * 128 + 16 * X.wave + X.l15] = acc[pt][i];
        }
        __syncthreads();
    }
}
DI void s2_phase(const Ctx& X) {
    unsigned char* const wsl = (unsigned char*)inp(29);
    const float* DEC = (const float*)(wsl + WS_DEC); const float* SST = (const float*)(wsl + WS_XRES); bf16* HIN = (bf16*)(wsl + WS_HIN);
    for (int e = blockIdx.x * 512 + X.tid; e < 4 * 16 * 2 * 8192; e += gridDim.x * 512) {
        const int pn = e & 8191, dir = (e >> 13) & 1, h = (e >> 14) & 15, b = e >> 18; float hc = 0.f;
#pragma unroll
        for (int i = 0; i < 18; ++i) { const int c = dir == 0 ? i : (i < 2 ? 1 - i : 19 - i); const size_t idx = ((size_t)((b * 18 + c) * 16 + h)) * 2 + dir;
            HIN[idx * 8192 + pn] = (bf16)f2bf(hc); hc = hc * DEC[idx] + SST[idx * 8192 + pn]; }
    }
}
DI void softmax_pv(f32x4 (&s)[4], float& m, float& lsum, f32x4 (&o)[8], const LAS bf16* VT, int q, int l15) {
    float mx = -3.0e38f;
#pragma unroll
    for (int mt = 0; mt < 4; ++mt)
#pragma unroll
        for (int i = 0; i < 4; ++i) mx = fmaxf(mx, s[mt][i]);
    mx = fmaxf(mx, __shfl_xor(mx, 16)); mx = fmaxf(mx, __shfl_xor(mx, 32));
    const float mn = fmaxf(m, mx), alpha = __builtin_amdgcn_exp2f(m - mn); m = mn;
    float ps = 0.f;
#pragma unroll
    for (int mt = 0; mt < 4; ++mt)
#pragma unroll
        for (int i = 0; i < 4; ++i) { const float p = __builtin_amdgcn_exp2f(s[mt][i] - mn); s[mt][i] = p; ps += p; }
    lsum = lsum * alpha + ps;
#pragma unroll
    for (int dt = 0; dt < 8; ++dt) o[dt] *= alpha;
#pragma unroll
    for (int kk = 0; kk < 2; ++kk) { const bf16x8 pf = pack8(s[2 * kk], s[2 * kk + 1]);
#pragma unroll
        for (int dt = 0; dt < 8; ++dt) { const LAS bf16* vp = VT + (16 * dt + l15) * 72 + 32 * kk + 4 * q; o[dt] = mfma16(lds_frag8x2(vp, vp + 16), pf, o[dt]); } }
}

DI void s3_item(const Args& a, const Ctx& X, int it) {
    unsigned char* const wsl = (unsigned char*)inp(29);
    LAS bf16* Cm = (LAS bf16*)X.lds; LAS bf16* Bm = (LAS bf16*)(X.lds + 34816); LAS bf16* XT = (LAS bf16*)(X.lds + 69632);
    LAS bf16* Hf = (LAS bf16*)(X.lds + 87040); LAS bf16* Gb = (LAS bf16*)(X.lds + 104448);
    LAS float* acf = (LAS float*)(X.lds + 121856); LAS float* acb = acf + 512; LAS float* dtf = acf + 1024; LAS float* dtb = acf + 1536;
    const bf16* XBC = (const bf16*)(wsl + WS_XBC); const float* DT = (const float*)(wsl + WS_DT); const float* ACUM = (const float*)(wsl + WS_ACUM);
    const bf16* HIN = (const bf16*)(wsl + WS_HIN); const float* ZX = (const float*)(wsl + WS_BIG); bf16* MIX = (bf16*)(wsl + WS_MIX);
    const int b = it / 72, c = (it >> 2) % 18, g = it & 3, r0 = chunk_row(b, c);
    __syncthreads();
    stage_N<128, 128>(Cm, 136, XBC + (size_t)r0 * 2048 + 1536 + g * 128, 2048, X.tid);
    stage_N<128, 128>(Bm, 136, XBC + (size_t)r0 * 2048 + 1024 + g * 128, 2048, X.tid);
    { const int hh = X.tid >> 7, l = X.tid & 127, h = 4 * g + hh; const size_t idx0 = ((size_t)((b * 18 + c) * 16 + h)) * 2;
      acf[hh * 128 + l] = ACUM[idx0 * 128 + l]; acb[hh * 128 + l] = ACUM[(idx0 + 1) * 128 + l];
      dtf[hh * 128 + l] = DT[(size_t)(r0 + l) * 32 + h]; dtb[hh * 128 + l] = DT[(size_t)(r0 + l) * 32 + 16 + h]; }
    __syncthreads();
    const int myl = 16 * X.wave + X.l15;
    bf16x8 cfr[4];
#pragma unroll
    for (int ks = 0; ks < 4; ++ks) cfr[ks] = lds_frag16(Cm + myl * 136 + 32 * ks + 8 * X.q);
    f32x4* USCR = (f32x4*)(wsl + WS_USCR) + (size_t)blockIdx.x * 8192;
    float ss = 0.f;
#pragma unroll 1
    for (int hh = 0; hh < 4; ++hh) {
        const int h = 4 * g + hh; const size_t idx0 = ((size_t)((b * 18 + c) * 16 + h)) * 2;
        __syncthreads();
        stage_T<128, 64>(XT, 136, XBC + (size_t)r0 * 2048 + h * 64, 2048, X.tid);
        stage_N<64, 128>(Hf, 136, HIN + idx0 * 8192, 128, X.tid);
        stage_N<64, 128>(Gb, 136, HIN + (idx0 + 1) * 8192, 128, X.tid);
        __syncthreads();
        const float afl = acf[hh * 128 + myl], abl = acb[hh * 128 + myl];
        f32x4 yv[4], yf[4], yb[4];
#pragma unroll
        for (int pt = 0; pt < 4; ++pt) { yv[pt] = (f32x4){0.f, 0.f, 0.f, 0.f}; yf[pt] = yv[pt]; yb[pt] = yv[pt]; }
#pragma unroll 1
        for (int kk = 0; kk < 4; ++kk) {
            f32x4 mv[2];
#pragma unroll
            for (int hf = 0; hf < 2; ++hf) { const int st = 2 * kk + hf; f32x4 cb = {0.f, 0.f, 0.f, 0.f};
#pragma unroll
                for (int ks = 0; ks < 4; ++ks) cb = mfma16(lds_frag16(Bm + (16 * st + X.l15) * 136 + 32 * ks + 8 * X.q), cfr[ks], cb);
#pragma unroll
                for (int i = 0; i < 4; ++i) { const int s = 16 * st + 4 * X.q + i;
                    const float ef = expf(afl - acf[hh * 128 + s]), eb = expf(abl - acb[hh * 128 + s]);
                    float cf = (s <= myl) ? dtf[hh * 128 + s] * ef : 0.f; cf += (s >= myl) ? dtb[hh * 128 + s] * eb : 0.f;
                    mv[hf][i] = cb[i] * cf; } }
            const bf16x8 mfr = pack8(mv[0], mv[1]);
#pragma unroll
            for (int pt = 0; pt < 4; ++pt) { const LAS bf16* xp = XT + (16 * pt + X.l15) * 136 + 32 * kk + 4 * X.q; yv[pt] = mfma16(lds_frag8x2(xp, xp + 16), mfr, yv[pt]); }
        }
#pragma unroll
        for (int ks = 0; ks < 4; ++ks)
#pragma unroll
            for (int pt = 0; pt < 4; ++pt) { yf[pt] = mfma16(lds_frag16(Hf + (16 * pt + X.l15) * 136 + 32 * ks + 8 * X.q), cfr[ks], yf[pt]);
                yb[pt] = mfma16(lds_frag16(Gb + (16 * pt + X.l15) * 136 + 32 * ks + 8 * X.q), cfr[ks], yb[pt]); }
        const float ef = expf(afl), eb = expf(abl), dsk = inp(17)[h];
#pragma unroll
        for (int pt = 0; pt < 4; ++pt) { const int p0 = 16 * pt + 4 * X.q; const f32x4 zv = *(const f32x4*)(ZX + (size_t)(r0 + myl) * ZXP + h * 64 + p0); f32x4 uv;
#pragma unroll
            for (int i = 0; i < 4; ++i) { const float xv = bf2f(XT[(p0 + i) * 136 + myl]); const float y = yv[pt][i] + ef * yf[pt][i] + eb * yb[pt][i];
                uv[i] = (y + dsk * xv) * silu_f(zv[i]); ss += uv[i] * uv[i]; }
            USCR[(hh * 4 + pt) * 512 + X.tid] = uv; }
    }
    ss += __shfl_xor(ss, 16); ss += __shfl_xor(ss, 32);
    const float rstd = 1.f / sqrtf(ss * (1.f / 256.f) + EPS);
#pragma unroll 1
    for (int hh = 0; hh < 4; ++hh)
#pragma unroll
        for (int pt = 0; pt < 4; ++pt) { const int ch = g * 256 + hh * 64 + 16 * pt + 4 * X.q; const f32x4 gg = *(const f32x4*)(inp(18) + ch); const f32x4 uv = USCR[(hh * 4 + pt) * 512 + X.tid];
            u32x2 w; w.x = pk2(uv[0] * rstd * gg[0], uv[1] * rstd * gg[1]); w.y = pk2(uv[2] * rstd * gg[2], uv[3] * rstd * gg[3]);
            *(u32x2*)(MIX + (size_t)(r0 + myl) * 2048 + ch) = w; }
}

DI void da_item(const Args& a, const Ctx& X, int it, float lam) {
    unsigned char* const wsl = (unsigned char*)inp(29);
    LAS bf16* KS = (LAS bf16*)X.lds; LAS bf16* VT = (LAS bf16*)(X.lds + 18432);
    const bf16* QK = (const bf16*)(wsl + WS_QK); const bf16* V = (const bf16*)(wsl + WS_V); bf16* MIX = (bf16*)(wsl + WS_MIX);
    const int b = it / 144, rem = it % 144, hp = rem / 18, qb = rem % 18; const bool isctx = qb < 2;
    const int q0row = isctx ? b * 256 + qb * 128 : CROWS + b * 2048 + (qb - 2) * 128, nkt = isctx ? 4 : 36;
    const int qrow = q0row + 16 * X.wave + X.l15;
    bf16x8 qf[2][2];
#pragma unroll
    for (int e = 0; e < 2; ++e)
#pragma unroll
        for (int ks = 0; ks < 2; ++ks) qf[e][ks] = *(const bf16x8*)(QK + (size_t)qrow * 2048 + (2 * hp + e) * 64 + 32 * ks + 8 * X.q);
    f32x4 o0[8], o1[8];
#pragma unroll
    for (int dt = 0; dt < 8; ++dt) { o0[dt] = (f32x4){0.f, 0.f, 0.f, 0.f}; o1[dt] = o0[dt]; }
    float m0 = -1.0e30f, m1 = -1.0e30f, l0 = 0.f, l1 = 0.f;
    for (int kt = 0; kt < nkt; ++kt) {
        const int kr0 = kt < 4 ? b * 256 + 64 * kt : CROWS + b * 2048 + 64 * (kt - 4);
        __syncthreads();
        stage_N<64, 64>(KS, 72, QK + (size_t)kr0 * 2048 + 1024 + (2 * hp) * 64, 2048, X.tid);
        stage_N<64, 64>(KS + 64 * 72, 72, QK + (size_t)kr0 * 2048 + 1024 + (2 * hp + 1) * 64, 2048, X.tid);
        stage_T<64, 128>(VT, 72, V + (size_t)kr0 * 1024 + hp * 128, 1024, X.tid);
        __syncthreads();
        { f32x4 s[4];
#pragma unroll
          for (int mt = 0; mt < 4; ++mt) { s[mt] = (f32x4){0.f, 0.f, 0.f, 0.f};
#pragma unroll
              for (int ks = 0; ks < 2; ++ks) s[mt] = mfma16(lds_frag16(KS + (16 * mt + X.l15) * 72 + 32 * ks + 8 * X.q), qf[0][ks], s[mt]); }
          softmax_pv(s, m0, l0, o0, VT, X.q, X.l15); }
        { f32x4 s[4];
#pragma unroll
          for (int mt = 0; mt < 4; ++mt) { s[mt] = (f32x4){0.f, 0.f, 0.f, 0.f};
#pragma unroll
              for (int ks = 0; ks < 2; ++ks) s[mt] = mfma16(lds_frag16(KS + 64 * 72 + (16 * mt + X.l15) * 72 + 32 * ks + 8 * X.q), qf[1][ks], s[mt]); }
          softmax_pv(s, m1, l1, o1, VT, X.q, X.l15); }
    }
    l0 += __shfl_xor(l0, 16); l0 += __shfl_xor(l0, 32); l1 += __shfl_xor(l1, 16); l1 += __shfl_xor(l1, 32);
    const float i0 = 1.f / l0, i1 = lam / l1; float ss = 0.f;
#pragma unroll
    for (int dt = 0; dt < 8; ++dt)
#pragma unroll
        for (int i = 0; i < 4; ++i) { const float v = o0[dt][i] * i0 - o1[dt][i] * i1; o0[dt][i] = v; ss += v * v; }
    ss += __shfl_xor(ss, 16); ss += __shfl_xor(ss, 32);
    const float rstd = 0.8f / sqrtf(ss * (1.f / 128.f) + EPS);
#pragma unroll
    for (int dt = 0; dt < 8; ++dt) { const int d = 16 * dt + 4 * X.q; const f32x4 gg = *(const f32x4*)(inp(23) + d);
        u32x2 w; w.x = pk2(o0[dt][0] * rstd * gg[0], o0[dt][1] * rstd * gg[1]); w.y = pk2(o0[dt][2] * rstd * gg[2], o0[dt][3] * rstd * gg[3]);
        *(u32x2*)(MIX + (size_t)qrow * 2048 + 1024 + hp * 128 + d) = w; }
}

DI void na_item(const Args& a, const Ctx& X, int it) {
    unsigned char* const wsl = (unsigned char*)inp(29);
    LAS bf16* KS = (LAS bf16*)X.lds; LAS bf16* VT = (LAS bf16*)(X.lds + 17408); LAS float* rpbL = (LAS float*)(X.lds + 35840);
    const bf16* QKV = (const bf16*)(wsl + WS_BIG); bf16* MIX = (bf16*)(wsl + WS_MIX);
    const int b = it >> 8, head = (it >> 4) & 15, rp = it & 15, half = X.wave >> 2, t = X.wave & 3, r = 2 * rp + half, qcol = 16 * t + X.l15;
    const int qrow = CROWS + b * 2048 + r * 64 + qcol;
    const int rs = min(max(r - 4, 0), 24), rs_lo = min(max(2 * rp - 4, 0), 24), rs_hi = min(max(2 * rp - 3, 0), 24) + 7;
    const int cs = min(max(qcol - 8, 0), 48);
    __syncthreads();
    for (int i = X.tid; i < 465; i += 512) rpbL[i] = inp(26)[head * 465 + i] * LOG2E;
    bf16x8 qf[4];
#pragma unroll
    for (int ks = 0; ks < 4; ++ks) qf[ks] = *(const bf16x8*)(QKV + (size_t)qrow * NIN1 + head * 128 + 32 * ks + 8 * X.q);
    f32x4 o[8];
#pragma unroll
    for (int dt = 0; dt < 8; ++dt) o[dt] = (f32x4){0.f, 0.f, 0.f, 0.f};
    float m = -1.0e30f, l = 0.f; const float SC = 0.08838834764831845f * LOG2E;
    const int ntile = (rs_hi - rs_lo + 1) + 4;
    for (int ti = 0; ti < ntile; ++ti) {
        const bool win = ti < (rs_hi - rs_lo + 1); const int ur = rs_lo + ti;
        const int kr0 = win ? CROWS + b * 2048 + ur * 64 : b * 256 + 64 * (ti - (rs_hi - rs_lo + 1));
        __syncthreads();
        stage_N<64, 128>(KS, 136, QKV + (size_t)kr0 * NIN1 + 2048 + head * 128, NIN1, X.tid);
        stage_T<64, 128>(VT, 72, QKV + (size_t)kr0 * NIN1 + 4096 + head * 128, NIN1, X.tid);
        __syncthreads();
        if (!win || (ur >= rs && ur < rs + 8)) {
            f32x4 s[4];
#pragma unroll
            for (int mt = 0; mt < 4; ++mt) { s[mt] = (f32x4){0.f, 0.f, 0.f, 0.f};
#pragma unroll
                for (int ks = 0; ks < 4; ++ks) s[mt] = mfma16(lds_frag16(KS + (16 * mt + X.l15) * 136 + 32 * ks + 8 * X.q), qf[ks], s[mt]); }
            if (win) { const int dr = ur - r + 7;
#pragma unroll
                for (int mt = 0; mt < 4; ++mt)
#pragma unroll
                    for (int i = 0; i < 4; ++i) { const int kc = 16 * mt + 4 * X.q + i; const bool ok = kc >= cs && kc < cs + 16; const int dc = min(max(kc - qcol + 15, 0), 30);
                        s[mt][i] = ok ? s[mt][i] * SC + rpbL[dr * 31 + dc] : -1.0e30f; } }
            else {
#pragma unroll
                for (int mt = 0; mt < 4; ++mt) s[mt] *= SC; }
            softmax_pv(s, m, l, o, VT, X.q, X.l15);
        }
    }
    l += __shfl_xor(l, 16); l += __shfl_xor(l, 32); const float il = 1.f / l;
#pragma unroll
    for (int dt = 0; dt < 8; ++dt) { const int d = 16 * dt + 4 * X.q;
        u32x2 w; w.x = pk2(o[dt][0] * il, o[dt][1] * il); w.y = pk2(o[dt][2] * il, o[dt][3] * il);
        *(u32x2*)(MIX + (size_t)qrow * 2048 + head * 128 + d) = w; }
}

DI void final_phase(const Args& a, const Ctx& X) {
    unsigned char* const wsl = (unsigned char*)inp(29);
    const float* XR = (const float*)(wsl + WS_XRES); const float* g = inp(8); float* outp = (float*)inp(28);
    for (int row = CROWS + X.gw; row < MROWS; row += X.ngw) {
        const float* xr = XR + (size_t)row * DM; f32x4 v[8]; float s = 0.f;
#pragma unroll
        for (int j = 0; j < 8; ++j) { v[j] = ((const f32x4*)xr)[X.lane + 64 * j]; s += (v[j][0] * v[j][0] + v[j][1] * v[j][1]) + (v[j][2] * v[j][2] + v[j][3] * v[j][3]); }
        s = wave_sum(s); const float rstd = 1.f / sqrtf(s * (1.f / DM) + EPS);
#pragma unroll
        for (int j = 0; j < 8; ++j) { const int c4 = X.lane + 64 * j; const f32x4 gg = ((const f32x4*)g)[c4]; ((f32x4*)(outp + (size_t)(row - CROWS) * DM))[c4] = v[j] * rstd * gg; }
    }
}
template <class Epi> DI void run_gemm(const Ctx& X, const bf16* A, const bf16* Bt, int M, int N, int K, const Epi& E) {
    pg8::Gemm g{A, Bt, M, N, K}; pg8::StaticOrder S; S.init(M, N, (int)gridDim.x, (int)blockIdx.x);
    pg8::gemm_phase<Epi, pg8::StaticOrder, false>(X.lds, g, S, E, nullptr);
}
#ifndef PH
#define PH 0xFFFFFFFFu
#endif
#define ON(k) if constexpr ((PH >> (k)) & 1u)
__global__ void __launch_bounds__(512) fwd_kernel(Args a) {
    extern __shared__ __attribute__((aligned(16))) unsigned char smem[];
    cg::grid_group grid = cg::this_grid();
    Ctx X; X.lds = (LAS unsigned char*)smem; X.tid = threadIdx.x; X.lane = X.tid & 63; X.wave = __builtin_amdgcn_readfirstlane(X.tid >> 6); X.q = X.lane >> 4; X.l15 = X.lane & 15;
    X.gw = blockIdx.x * 8 + X.wave; X.ngw = gridDim.x * 8; X.ws = nullptr;
    float lam; { const float p1 = inp(19)[X.lane] * inp(20)[X.lane], p2 = inp(21)[X.lane] * inp(22)[X.lane]; lam = expf(wave_sum(p1)) - expf(wave_sum(p2)) + 0.2f; }
#define WSP(T, off) ((T*)((unsigned char*)inp(29) + (off)))
#define MOD0P WSP(float, WS_MOD)
#define MOD1P (WSP(float, WS_MOD) + 5 * 12288)
#define XRESP WSP(float, WS_XRES)
#define XRESBP (WSP(float, WS_XRES) + (size_t)CROWS * DM)
    ON(0) p0_phase(a, X);
    grid.sync();
    ON(1) norm_mod_phase(X, inp(2), inp(0), inp(6), MOD0P, 0, 2048, WSP(bf16, WS_H), 0, MROWS);
    grid.sync();
    ON(2) { pg8::EpiF32 E{WSP(float, WS_BIG), ZXP, nullptr}; run_gemm(X, WSP(bf16, WS_H), WSP(const bf16, WS_WIN0), MROWS, NIN0, DM, E); }
    grid.sync();
    ON(3) post_phase(a, X);
    grid.sync();
    ON(4) s1_phase(a, X);
    grid.sync();
    ON(5) s2_phase(X);
    grid.sync();
    ON(6) for (int it = blockIdx.x; it < 288; it += gridDim.x) s3_item(a, X, it);
    ON(7) for (int it = blockIdx.x; it < 576; it += gridDim.x) da_item(a, X, it, lam);
    grid.sync();
    ON(8) { EpiResid E{inp(2), inp(0), MOD0P, 4096, XRESP, 0}; run_gemm(X, WSP(bf16, WS_MIX), WSP(const bf16, WS_WOUT0), MROWS, DM, DM, E); }
    grid.sync();
    ON(9) norm_mod_phase(X, XRESP, XRESBP, inp(7), MOD0P, 6144, 8192, WSP(bf16, WS_H), 0, MROWS);
    grid.sync();
    ON(10) { EpiSwiGLU E{WSP(bf16, WS_BIG), 0}; run_gemm(X, WSP(bf16, WS_H), WSP(const bf16, WS_WUP0), MROWS, 2 * DFF, DM, E); }
    grid.sync();
    ON(11) { EpiResid E{XRESP, XRESBP, MOD0P, 10240, XRESP, 0}; run_gemm(X, WSP(bf16, WS_BIG), WSP(const bf16, WS_WDN0), MROWS, DM, DFF, E); }
    grid.sync();
    ON(12) norm_mod_phase(X, XRESP, XRESBP, inp(6) + DM, MOD1P, 0, 2048, WSP(bf16, WS_H), 0, MROWS);
    grid.sync();
    ON(13) { pg8::EpiBf16<0> E{WSP(bf16, WS_BIG), NIN1, nullptr, 0, 0}; run_gemm(X, WSP(bf16, WS_H), WSP(const bf16, WS_WIN1), MROWS, NIN1, DM, E); }
    grid.sync();
    ON(14) for (int it = blockIdx.x; it < 1024; it += gridDim.x) na_item(a, X, it);
    grid.sync();
    ON(15) { EpiResid E{XRESP, XRESBP, MOD1P, 4096, XRESP, CROWS}; run_gemm(X, WSP(bf16, WS_MIX) + (size_t)CROWS * DM, WSP(const bf16, WS_WOUT1), MROWS - CROWS, DM, DM, E); }
    grid.sync();
    ON(16) norm_mod_phase(X, XRESP, XRESBP, inp(7) + DM, MOD1P, 6144, 8192, WSP(bf16, WS_H), CROWS, MROWS);
    grid.sync();
    ON(17) { EpiSwiGLU E{WSP(bf16, WS_BIG), CROWS}; run_gemm(X, WSP(bf16, WS_H) + (size_t)CROWS * DM, WSP(const bf16, WS_WUP1), MROWS - CROWS, 2 * DFF, DM, E); }
    grid.sync();
    ON(18) { EpiResid E{XRESP, XRESBP, MOD1P, 10240, XRESP, CROWS}; run_gemm(X, WSP(bf16, WS_BIG) + (size_t)CROWS * DFF, WSP(const bf16, WS_WDN1), MROWS - CROWS, DM, DFF, E); }
    grid.sync();
    ON(19) final_phase(a, X);
}

extern "C" void kernel_launch(void* const* d_in, const int* in_sizes, int n_in, void* d_out, int out_size, void* d_ws, size_t ws_size, hipStream_t stream) {
    static int grid = 0;
    if (grid == 0) {
        if (n_in != 28 || ws_size < WS_END) { fprintf(stderr, "kernel_launch: unexpected n_in %d / ws_size %zu (need %zu)\n", n_in, ws_size, (size_t)WS_END); grid = -1; return; }
        int dev = 0, cus = 0, per_cu = 0;
        if (hipGetDevice(&dev) != hipSuccess || hipDeviceGetAttribute(&cus, hipDeviceAttributeMultiprocessorCount, dev) != hipSuccess) { grid = -1; return; }
        if (hipFuncSetAttribute((const void*)fwd_kernel, hipFuncAttributeMaxDynamicSharedMemorySize, LDS_BYTES) != hipSuccess) { fprintf(stderr, "kernel_launch: hipFuncSetAttribute failed\n"); grid = -1; return; }
        if (hipOccupancyMaxActiveBlocksPerMultiprocessor(&per_cu, (const void*)fwd_kernel, 512, LDS_BYTES) != hipSuccess || per_cu < 1) { fprintf(stderr, "kernel_launch: occupancy query gave %d\n", per_cu); per_cu = 1; }
        (void)hipGetLastError();
        grid = cus * per_cu;
    }
    if (grid < 0) return;
    Args a{};
    for (int i = 0; i < 28; ++i) a.in[i] = (const float*)d_in[i];
    a.out = (float*)d_out; a.ws = (unsigned char*)d_ws;
    void* args[] = {&a};
    hipError_t e = hipLaunchCooperativeKernel((const void*)fwd_kernel, dim3(grid), dim3(512), args, LDS_BYTES, stream);
    if (e != hipSuccess) fprintf(stderr, "kernel_launch: cooperative launch failed: %s (grid %d)\n", hipGetErrorString(e), grid);
}
```

```cpp
#include <hip/hip_runtime.h>
#include <hip/hip_cooperative_groups.h>
#include <cstdio>
#include <cstdint>
namespace cg = cooperative_groups;
namespace pg8 {
#define PG8_LAS __attribute__((address_space(3)))
typedef unsigned short bf16_t;
typedef short bf16x8 __attribute__((ext_vector_type(8)));
typedef float f32x4 __attribute__((ext_vector_type(4)));
typedef unsigned u32x4 __attribute__((ext_vector_type(4)));
constexpr int BM = 256, BK = 64, HALF = 128, HTB = HALF * BK * 2  , STAGE_BYTES = 8 * HTB, NXCD = 8, WGM = 4;

__host__ __device__ __forceinline__ int lds_byte(int r, int c) { const int st = (r >> 4) * 2 + (c >> 5), rr = r & 15, cc = c & 31, ob = rr * 64 + cc * 2; return st * 1024 + (ob ^ (((ob >> 9) & 1) << 5)); }
__host__ __device__ __forceinline__ void stage_rc(int b, int& R, int& C) { const int st = b / 1024, sb = b % 1024, swz = sb ^ (((sb >> 9) & 1) << 5); R = (st >> 1) * 16 + swz / 64; C = (st & 1) * 32 + (swz % 64) / 2; }
__host__ __device__ __forceinline__ int perm32(int rho) { const int n = rho >> 4, i = rho & 15; return 8 * (i >> 2) + 4 * n + (i & 3); }

struct Unit { int pm, pn, koff, nt; };
struct Gemm { const bf16_t* A; const bf16_t* Bt; int M, N, K; };

struct StaticOrder {
    int nM, nN, nwg, G, c, ntf;
    __host__ __device__ void init(int M, int N, int G_, int c_) { nM = M / BM; nN = N / BM; nwg = nM * nN; G = G_; c = c_; }
    __host__ __device__ bool next(int i, Unit& u) const {
        const long L = (long)i * G + c; if (L >= nwg) return false;
        int wgid = (int)L; { const int q = nwg / NXCD, r = nwg % NXCD, xcd = wgid % NXCD, off = wgid / NXCD; wgid = (xcd < r ? xcd * (q + 1) : r * (q + 1) + (xcd - r) * q) + off; }
        const int nig = WGM * nN, gid = wgid / nig, fm = gid * WGM, gsz = (nM - fm) < WGM ? (nM - fm) : WGM;
        u.pm = fm + ((wgid % nig) % gsz); u.pn = (wgid % nig) / gsz; u.koff = 0; u.nt = ntf; return true;
    }
    __device__ __forceinline__ void a_ready(const Unit&) const {}
    __device__ __forceinline__ void done(const Unit&) const {}
};
__device__ __forceinline__ unsigned cvt_pk_bf16(float lo, float hi) { unsigned r; asm volatile("v_cvt_pk_bf16_f32 %0, %1, %2" : "=v"(r) : "v"(lo), "v"(hi)); return r; }
typedef float f32x2 __attribute__((ext_vector_type(2)));
__device__ __forceinline__ f32x2 gelu_pk(f32x2 v) {
    const f32x2 av = __builtin_elementwise_abs(v), d = av * 0.2316418882f + 1.0f;
    f32x2 t; t.x = __builtin_amdgcn_rcpf(d.x); t.y = __builtin_amdgcn_rcpf(d.y);
    f32x2 q = t * 0.5307027145f + (-0.7265760135f); q = q * t + 0.7107068705f; q = q * t + (-0.142248368f); q = q * t + 0.127414796f; q = q * t;
    const f32x2 s = (v * v) * (-0.72134752044f);
    f32x2 e; e.x = __builtin_amdgcn_exp2f(s.x); e.y = __builtin_amdgcn_exp2f(s.y);
    const f32x2 m = v * (q * e), r = v - m;
    f32x2 o; o.x = v.x < 0.f ? m.x : r.x; o.y = v.y < 0.f ? m.y : r.y; return o;
}

struct EpiF32 {
    static constexpr bool PERM = false, AFTER_DRAIN = false;
    float* C; int ldc; const float* bias;
    __device__ __forceinline__ void operator()(const f32x4 (&acc)[2][2][4][2], const Unit& u, int wr, int wc, int fr, int fq) const {
        const int row0 = u.pm * BM + wr * 64 + fr, col0 = u.pn * BM + wc * 32 + 4 * fq;
        f32x4 bv[2][2];
#pragma unroll
        for (int bj = 0; bj < 2; ++bj)
#pragma unroll
            for (int n = 0; n < 2; ++n) bv[bj][n] = bias ? *(const f32x4*)(bias + col0 + bj * HALF + n * 16) : (f32x4){0.f, 0.f, 0.f, 0.f};
#pragma unroll
        for (int ai = 0; ai < 2; ++ai)
#pragma unroll
            for (int m = 0; m < 4; ++m) { float* rowp = C + (size_t)(row0 + ai * HALF + m * 16) * ldc + col0;
#pragma unroll
                for (int bj = 0; bj < 2; ++bj)
#pragma unroll
                    for (int n = 0; n < 2; ++n) *(f32x4*)(rowp + bj * HALF + n * 16) = acc[ai][bj][m][n] + bv[bj][n]; }
    }
};
template <int ACT  > struct EpiBf16 {
    static constexpr bool PERM = true, AFTER_DRAIN = false;
    bf16_t* O; int ldc; const float* bias; int split_cols; size_t split_stride;
    __device__ __forceinline__ void operator()(const f32x4 (&acc)[2][2][4][2], const Unit& u, int wr, int wc, int fr, int fq) const {
        const int row0 = u.pm * BM + wr * 64 + fr; int colt = u.pn * BM; bf16_t* base = O;
        if (split_cols) { const int t = colt / split_cols; base += (size_t)t * split_stride; colt -= t * split_cols; }
        const int col0 = colt + wc * 32 + 8 * fq, bcol0 = u.pn * BM + wc * 32 + 8 * fq;
        f32x4 bv[2][2];
#pragma unroll
        for (int bj = 0; bj < 2; ++bj)
#pragma unroll
            for (int n = 0; n < 2; ++n) bv[bj][n] = bias ? *(const f32x4*)(bias + bcol0 + bj * HALF + 4 * n) : (f32x4){0.f, 0.f, 0.f, 0.f};
#pragma unroll
        for (int ai = 0; ai < 2; ++ai)
#pragma unroll
            for (int m = 0; m < 4; ++m) { bf16_t* rowp = base + (size_t)(row0 + ai * HALF + m * 16) * ldc + col0;
#pragma unroll
                for (int bj = 0; bj < 2; ++bj) { f32x4 v0 = acc[ai][bj][m][0] + bv[bj][0], v1 = acc[ai][bj][m][1] + bv[bj][1];
                    if (ACT == 1) { f32x2 a = gelu_pk((f32x2){v0[0], v0[1]}), b = gelu_pk((f32x2){v0[2], v0[3]}), c = gelu_pk((f32x2){v1[0], v1[1]}), d = gelu_pk((f32x2){v1[2], v1[3]});
                        v0 = (f32x4){a.x, a.y, b.x, b.y}; v1 = (f32x4){c.x, c.y, d.x, d.y}; }
                    if (ACT == 2) {
#pragma unroll
                        for (int j = 0; j < 4; ++j) { v0[j] = 0.5f * v0[j] * (1.0f + erff(v0[j] * 0.70710678f)); v1[j] = 0.5f * v1[j] * (1.0f + erff(v1[j] * 0.70710678f)); } }
                    u32x4 w; w.x = cvt_pk_bf16(v0[0], v0[1]); w.y = cvt_pk_bf16(v0[2], v0[3]); w.z = cvt_pk_bf16(v1[0], v1[1]); w.w = cvt_pk_bf16(v1[2], v1[3]);
                    *(u32x4*)(rowp + bj * HALF) = w; } }
    }
};

template <class Epi, class Sched, bool STAMP = false>
__device__ __forceinline__ void gemm_phase(PG8_LAS unsigned char* lds, const Gemm g, const Sched& S, const Epi& E, unsigned long long* stamps) {
    int tid_ = threadIdx.x; asm volatile("" : "+v"(tid_)); const int tid = tid_, wid = __builtin_amdgcn_readfirstlane(tid >> 6), lane = tid & 63, wr = wid >> 2, wc = wid & 3, fr = lane & 15, fq = lane >> 4;
    const int K = g.K;
    int ts_lo = 0, ts_hi = 0, nts = 0; const unsigned long long rt_entry = STAMP ? (unsigned long long)wall_clock64() : 0ull;
#define PG8_STAMP() do { if (STAMP && wid == 0 && nts < 64) { const unsigned long long _c = (unsigned long long)clock64(); \
        ts_lo = (lane == nts) ? (int)(unsigned)_c : ts_lo; ts_hi = (lane == nts) ? (int)(unsigned)(_c >> 32) : ts_hi; ++nts; } } while (0)
    PG8_STAMP();
    unsigned voffA[2], voffB[2];
#pragma unroll
    for (int i = 0; i < 2; ++i) { int R, C; stage_rc(tid * 16 + i * 8192, R, C); const int Rb = Epi::PERM ? ((R & ~31) + perm32(R & 31)) : R;
        voffA[i] = (unsigned)(R * K + C) * 2u; voffB[i] = (unsigned)(Rb * K + C) * 2u; }
    const size_t kstep = (size_t)(BK * 2);
    const size_t hstep = (size_t)HALF * K * 2;
    const size_t tstep = 2 * hstep;
    const unsigned ldsw = (unsigned)wid * 1024u;
    const int aoff = lds_byte(wr * 64 + fr, fq * 8), boff = lds_byte(wc * 32 + fr, fq * 8);
#define PG8_SA(b, h) (((b) * 2 + (h)) * HTB)
#define PG8_SB(b, h) ((4 + (b) * 2 + (h)) * HTB)
#define PG8_STAGE(bufoff, gbase, voff) do { _Pragma("unroll") for (int _i = 0; _i < 2; ++_i) \
        __builtin_amdgcn_global_load_lds((const unsigned*)((const char*)(gbase) + (voff)[_i]), (PG8_LAS unsigned*)(lds + (bufoff) + ldsw + _i * 8192), 16, 0, 0); } while (0)
#define PG8_LDA(dst, b, h) do { _Pragma("unroll") for (int m = 0; m < 4; ++m) _Pragma("unroll") for (int k = 0; k < 2; ++k) dst[m][k] = *(const PG8_LAS bf16x8*)(lds + PG8_SA(b, h) + aoff + m * 2048 + k * 1024); } while (0)
#define PG8_LDB(dst, b, h) do { _Pragma("unroll") for (int n = 0; n < 2; ++n) _Pragma("unroll") for (int k = 0; k < 2; ++k) dst[n][k] = *(const PG8_LAS bf16x8*)(lds + PG8_SB(b, h) + boff + n * 2048 + k * 1024); } while (0)
#define PG8_MMA(ai, bj, At, Bt) do { __builtin_amdgcn_s_setprio(1); _Pragma("unroll") for (int m = 0; m < 4; ++m) _Pragma("unroll") for (int n = 0; n < 2; ++n) _Pragma("unroll") for (int k = 0; k < 2; ++k) \
        acc[ai][bj][m][n] = __builtin_amdgcn_mfma_f32_16x16x32_bf16(Bt[n][k], At[m][k], acc[ai][bj][m][n], 0, 0, 0); __builtin_amdgcn_s_setprio(0); } while (0)
#define PG8_WAIT_V(n) asm volatile("s_waitcnt vmcnt(" #n ")" ::: "memory")
#define PG8_WAIT_L(n) asm volatile("s_waitcnt lgkmcnt(" #n ")" ::: "memory")
#define PG8_BAR __builtin_amdgcn_s_barrier()
#define PG8_SCHED __builtin_amdgcn_sched_barrier(0)
    Unit cur, nxt; int ui = 0;
    if (!S.next(0, cur)) return;
    f32x4 acc[2][2][4][2];
#pragma unroll
    for (int a = 0; a < 2; ++a)
#pragma unroll
        for (int b = 0; b < 2; ++b)
#pragma unroll
            for (int m = 0; m < 4; ++m)
#pragma unroll
                for (int n = 0; n < 2; ++n) acc[a][b][m][n] = (f32x4){0.f, 0.f, 0.f, 0.f};
    bf16x8 At[4][2], B0[2][2], B1[2][2];
    const char* cA = (const char*)g.A + (size_t)cur.pm * tstep + cur.koff; const char* cB = (const char*)g.Bt + (size_t)cur.pn * tstep + cur.koff;
    S.a_ready(cur);
    PG8_STAGE(PG8_SB(0, 0), cB, voffB); PG8_STAGE(PG8_SB(0, 1), cB + hstep, voffB); PG8_STAGE(PG8_SA(0, 0), cA, voffA); PG8_STAGE(PG8_SA(0, 1), cA + hstep, voffA);
    if (wr == 1) PG8_BAR;
    PG8_WAIT_V(2); PG8_BAR;
    PG8_STAGE(PG8_SB(1, 0), cB + kstep, voffB); PG8_STAGE(PG8_SA(1, 0), cA + kstep, voffA); PG8_STAGE(PG8_SB(1, 1), cB + hstep + kstep, voffB);
    PG8_WAIT_V(6); PG8_BAR;
    PG8_STAMP();
    for (;;) {
        const bool has_next = S.next(ui + 1, nxt);
        const char* nA = has_next ? (const char*)g.A + (size_t)nxt.pm * tstep + nxt.koff : cA; const char* nB = has_next ? (const char*)g.Bt + (size_t)nxt.pn * tstep + nxt.koff : cB;
        const int nt = cur.nt;
        for (int t = 0; t < nt; t += 2) {
            const bool last = (t == nt - 2);
            const char* a1 = cA + (size_t)(t + 1) * kstep;
            const char* a2 = last ? nA : cA + (size_t)(t + 2) * kstep; const char* b2 = last ? nB : cB + (size_t)(t + 2) * kstep;
            const char* a3 = a2 + kstep; const char* b3 = b2 + kstep;
            if (last && has_next) S.a_ready(nxt);
            PG8_LDB(B0, 0, 0); PG8_LDB(B1, 0, 1); PG8_SCHED; PG8_LDA(At, 0, 0); PG8_STAGE(PG8_SA(1, 1), a1 + hstep, voffA);
            PG8_WAIT_V(8); PG8_WAIT_L(0); PG8_BAR; PG8_MMA(0, 0, At, B0); PG8_MMA(0, 1, At, B1); PG8_BAR; PG8_SCHED;
            PG8_LDA(At, 0, 1); PG8_STAGE(PG8_SB(0, 0), b2, voffB); PG8_STAGE(PG8_SB(0, 1), b2 + hstep, voffB); PG8_STAGE(PG8_SA(0, 0), a2, voffA);
            PG8_WAIT_V(8); PG8_WAIT_L(0); PG8_BAR; PG8_MMA(1, 0, At, B0); PG8_MMA(1, 1, At, B1); PG8_BAR; PG8_SCHED;
            PG8_LDB(B0, 1, 0); PG8_LDB(B1, 1, 1); PG8_SCHED; PG8_LDA(At, 1, 0); PG8_STAGE(PG8_SA(0, 1), a2 + hstep, voffA);
            PG8_WAIT_V(8); PG8_WAIT_L(0); PG8_BAR; PG8_MMA(0, 0, At, B0); PG8_MMA(0, 1, At, B1); PG8_BAR; PG8_SCHED;
            PG8_LDA(At, 1, 1); PG8_STAGE(PG8_SB(1, 0), b3, voffB); PG8_STAGE(PG8_SB(1, 1), b3 + hstep, voffB); PG8_STAGE(PG8_SA(1, 0), a3, voffA);
            PG8_WAIT_V(8); PG8_WAIT_L(0); PG8_BAR; PG8_MMA(1, 0, At, B0); PG8_MMA(1, 1, At, B1); PG8_BAR; PG8_SCHED;
        }
        PG8_STAMP();
        if (wr == 0) PG8_BAR;
        if constexpr (!Epi::AFTER_DRAIN) { E(acc, cur, wr, wc, fr, fq); S.done(cur); }
        PG8_STAMP();
        if (!has_next) break;
#pragma unroll
        for (int a = 0; a < 2; ++a)
#pragma unroll
            for (int b = 0; b < 2; ++b)
#pragma unroll
                for (int m = 0; m < 4; ++m)
#pragma unroll
                    for (int n = 0; n < 2; ++n) acc[a][b][m][n] = (f32x4){0.f, 0.f, 0.f, 0.f};
        cur = nxt; cA = nA; cB = nB; ++ui;
        if (wr == 1) PG8_BAR;
    }
    PG8_WAIT_V(0);
    PG8_BAR;
    if constexpr (Epi::AFTER_DRAIN) { E.fused(acc, cur, wr, wc, fr, fq, lds, wid, lane); S.done(cur); }
    PG8_STAMP();
    if (STAMP && wid == 0) { stamps[lane] = lane < nts ? (((unsigned long long)(unsigned)ts_hi << 32) | (unsigned)ts_lo) : 0ull;
        if (lane == 62) stamps[62] = rt_entry; if (lane == 63) stamps[63] = (unsigned long long)wall_clock64(); }
#undef PG8_STAMP
#undef PG8_SA
#undef PG8_SB
#undef PG8_STAGE
#undef PG8_LDA
#undef PG8_LDB
#undef PG8_MMA
#undef PG8_WAIT_V
#undef PG8_WAIT_L
#undef PG8_BAR
#undef PG8_SCHED
}
}
#define DI __device__ __forceinline__
#define LAS __attribute__((address_space(3)))
typedef unsigned short bf16;
typedef short bf16x8 __attribute__((ext_vector_type(8)));
typedef short bf16x4 __attribute__((ext_vector_type(4)));
typedef float f32x4 __attribute__((ext_vector_type(4)));
typedef unsigned u32x4 __attribute__((ext_vector_type(4)));
typedef unsigned u32x2 __attribute__((ext_vector_type(2)));

constexpr int DM = 2048, MROWS = 9216, CROWS = 1024, DFF = 5632, NIN0 = 6400, NIN1 = 6144, ZXP = 6144;
constexpr float EPS = 1e-6f, LOG2E = 1.4426950408889634f;
constexpr size_t MiB = 1u << 20;
constexpr size_t WS_WIN0 = 0, WS_WOUT0 = 25 * MiB, WS_WUP0 = 33 * MiB, WS_WDN0 = 77 * MiB, WS_WIN1 = 99 * MiB, WS_WOUT1 = 123 * MiB, WS_WUP1 = 131 * MiB, WS_WDN1 = 175 * MiB;
constexpr size_t WS_MOD = 197 * MiB, WS_XRES = 198 * MiB  , WS_H = 270 * MiB, WS_MIX = 306 * MiB, WS_BIG = 342 * MiB  ;
constexpr size_t WS_XBC = 567 * MiB, WS_QK = 603 * MiB, WS_V = 639 * MiB, WS_DT = 657 * MiB, WS_ACUM = 659 * MiB, WS_DEC = 661 * MiB, WS_HIN = 662 * MiB, WS_USCR = 698 * MiB  , WS_PART = 730 * MiB  , WS_BAR = 762 * MiB  , WS_END = 763 * MiB;
constexpr int LDS_BYTES = 147456;

struct Args { const float* in[28]; float* out; unsigned char* ws; };
typedef const float* fptr_t;
__device__ __forceinline__ const float* inp(int i) { const volatile __attribute__((address_space(4))) fptr_t* kp = (const volatile __attribute__((address_space(4))) fptr_t*)__builtin_amdgcn_kernarg_segment_ptr(); return kp[i]; }

typedef float f32x2_t __attribute__((ext_vector_type(2)));
typedef __bf16 bf16x2_t __attribute__((ext_vector_type(2)));
DI unsigned pk2(float lo, float hi) { const f32x2_t v = {lo, hi}; return __builtin_bit_cast(unsigned, __builtin_convertvector(v, bf16x2_t)); }
DI unsigned f2bf(float f) { return pk2(f, 0.f) & 0xffffu; }
DI float bf2f(unsigned short b) { return __uint_as_float(((unsigned)b) << 16); }
DI float wave_sum(float v) {
#pragma unroll
    for (int o = 1; o < 64; o <<= 1) v += __shfl_xor(v, o);
    return v; }
DI float silu_f(float v) { return v * __builtin_amdgcn_rcpf(1.f + __expf(-v)); }
DI f32x4 mfma16(bf16x8 a, bf16x8 b, f32x4 c) { return __builtin_amdgcn_mfma_f32_16x16x32_bf16(a, b, c, 0, 0, 0); }
DI int row_batch(int row) { return row < CROWS ? 4 : (row - CROWS) >> 11; }
DI int chunk_row(int b, int c) { return c < 2 ? b * 256 + c * 128 : CROWS + b * 2048 + (c - 2) * 128; }

template <int R, int C> DI void stage_N(LAS bf16* dst, int dp, const bf16* src, size_t gp, int tid) {
#pragma unroll
    for (int ch = tid; ch < R * C / 8; ch += 512) { const int r = ch / (C / 8), c8 = ch % (C / 8);
        *(LAS u32x4*)(dst + r * dp + c8 * 8) = *(const u32x4*)(src + (size_t)r * gp + c8 * 8); }
}
template <int R, int C> DI void stage_T(LAS bf16* dst, int dp, const bf16* src, size_t gp, int tid) {
#pragma unroll
    for (int ch = tid; ch < R * C / 8; ch += 512) { const int r = ch % R, c8 = ch / R;
        const u32x4 v = *(const u32x4*)(src + (size_t)r * gp + c8 * 8);
        LAS bf16* d = dst + (c8 * 8) * dp + r;
        d[0] = (bf16)(v.x & 0xffffu); d[dp] = (bf16)(v.x >> 16); d[2 * dp] = (bf16)(v.y & 0xffffu); d[3 * dp] = (bf16)(v.y >> 16);
        d[4 * dp] = (bf16)(v.z & 0xffffu); d[5 * dp] = (bf16)(v.z >> 16); d[6 * dp] = (bf16)(v.w & 0xffffu); d[7 * dp] = (bf16)(v.w >> 16); }
}
DI bf16x8 lds_frag16(const LAS bf16* p) { return *(const LAS bf16x8*)p; }
DI bf16x8 lds_frag8x2(const LAS bf16* p0, const LAS bf16* p1) { const bf16x4 a = *(const LAS bf16x4*)p0, b = *(const LAS bf16x4*)p1; return __builtin_shufflevector(a, b, 0, 1, 2, 3, 4, 5, 6, 7); }
DI bf16x8 pack8(const f32x4 a, const f32x4 b) { u32x4 w; w.x = pk2(a[0], a[1]); w.y = pk2(a[2], a[3]); w.z = pk2(b[0], b[1]); w.w = pk2(b[2], b[3]); return __builtin_bit_cast(bf16x8, w); }

struct EpiResid {
    static constexpr bool PERM = false, AFTER_DRAIN = false;
    const float* resA; const float* resB; const float* mod; int goff; float* out; int row_base; int ntfull; float* part;
    __device__ __forceinline__ void operator()(const pg8::f32x4 (&acc)[2][2][4][2], const pg8::Unit& u, int wr, int wc, int fr, int fq) const {
        const int rowt = row_base + u.pm * 256; const int brow = row_batch(rowt);
        const int row0 = rowt + wr * 64 + fr, col0 = u.pn * 256 + wc * 32 + 4 * fq;
        const float* gp = mod + (size_t)brow * 12288 + goff + col0;
        f32x4 gv[2][2];
#pragma unroll
        for (int bj = 0; bj < 2; ++bj)
#pragma unroll
            for (int n = 0; n < 2; ++n) gv[bj][n] = *(const f32x4*)(gp + bj * 128 + n * 16);
        if (u.nt != ntfull) {
            float* pb = part + (size_t)(u.koff / (u.nt * 128)) * CROWS * DM;
#pragma unroll
            for (int ai = 0; ai < 2; ++ai)
#pragma unroll
                for (int m = 0; m < 4; ++m) { float* op = pb + (size_t)(row0 + ai * 128 + m * 16) * DM + col0;
#pragma unroll
                    for (int bj = 0; bj < 2; ++bj)
#pragma unroll
                        for (int n = 0; n < 2; ++n) *(f32x4*)(op + bj * 128 + n * 16) = gv[bj][n] * acc[ai][bj][m][n]; }
            return;
        }
#pragma unroll
        for (int ai = 0; ai < 2; ++ai)
#pragma unroll
            for (int m = 0; m < 4; ++m) { const int row = row0 + ai * 128 + m * 16;
                const float* rp = (row < CROWS ? resA + (size_t)row * DM : resB + (size_t)(row - CROWS) * DM) + col0; float* op = out + (size_t)row * DM + col0;
#pragma unroll
                for (int bj = 0; bj < 2; ++bj)
#pragma unroll
                    for (int n = 0; n < 2; ++n) { const f32x4 rv = *(const f32x4*)(rp + bj * 128 + n * 16); *(f32x4*)(op + bj * 128 + n * 16) = rv + gv[bj][n] * acc[ai][bj][m][n]; } }
    }
};
struct EpiSwiGLU {
    static constexpr bool PERM = true, AFTER_DRAIN = false;
    bf16* O; int row_base;
    __device__ __forceinline__ void operator()(const pg8::f32x4 (&acc)[2][2][4][2], const pg8::Unit& u, int wr, int wc, int fr, int fq) const {
        const int row0 = row_base + u.pm * 256 + wr * 64 + fr, col0 = u.pn * 128 + wc * 32 + 8 * fq;
#pragma unroll
        for (int ai = 0; ai < 2; ++ai)
#pragma unroll
            for (int m = 0; m < 4; ++m) { bf16* op = O + (size_t)(row0 + ai * 128 + m * 16) * DFF + col0;
                f32x4 v0, v1;
#pragma unroll
                for (int j = 0; j < 4; ++j) { const float a0 = acc[ai][0][m][0][j], a1 = acc[ai][0][m][1][j]; v0[j] = a0 * __builtin_amdgcn_rcpf(1.f + __expf(-a0)) * acc[ai][1][m][0][j]; v1[j] = a1 * __builtin_amdgcn_rcpf(1.f + __expf(-a1)) * acc[ai][1][m][1][j]; }
                u32x4 w; w.x = pk2(v0[0], v0[1]); w.y = pk2(v0[2], v0[3]); w.z = pk2(v1[0], v1[1]); w.w = pk2(v1[2], v1[3]);
                *(u32x4*)op = w; }
    }
};
struct EpiInProj0 {
    static constexpr bool PERM = true, AFTER_DRAIN = false;
    bf16* O; float* dtraw;
    __device__ __forceinline__ void operator()(const pg8::f32x4 (&acc)[2][2][4][2], const pg8::Unit& u, int wr, int wc, int fr, int fq) const {
        const int row0 = u.pm * 256 + wr * 64 + fr;
        if (u.pn == 24) {
            if (wc == 0) {
#pragma unroll
                for (int ai = 0; ai < 2; ++ai)
#pragma unroll
                    for (int m = 0; m < 4; ++m) { float* dp = dtraw + (size_t)(row0 + ai * 128 + m * 16) * 32 + 8 * fq; *(f32x4*)dp = acc[ai][0][m][0]; *(f32x4*)(dp + 4) = acc[ai][0][m][1]; } }
            return;
        }
        const int col0 = u.pn * 256 + wc * 32 + 8 * fq;
#pragma unroll
        for (int ai = 0; ai < 2; ++ai)
#pragma unroll
            for (int m = 0; m < 4; ++m) { bf16* rowp = O + (size_t)(row0 + ai * 128 + m * 16) * ZXP + col0;
#pragma unroll
                for (int bj = 0; bj < 2; ++bj) { const f32x4 v0 = acc[ai][bj][m][0], v1 = acc[ai][bj][m][1];
                    u32x4 w; w.x = pk2(v0[0], v0[1]); w.y = pk2(v0[2], v0[3]); w.z = pk2(v1[0], v1[1]); w.w = pk2(v1[2], v1[3]);
                    *(u32x4*)(rowp + bj * 128) = w; } }
    }
};
DI f32x4 bf4_to_f32(u32x2 w) { f32x4 r; r[0] = __uint_as_float(w.x << 16); r[1] = __uint_as_float(w.x & 0xffff0000u); r[2] = __uint_as_float(w.y << 16); r[3] = __uint_as_float(w.y & 0xffff0000u); return r; }
struct EpiBf16N {
    static constexpr bool PERM = true, AFTER_DRAIN = false;
    bf16* O; int ldc;
    __device__ __forceinline__ void operator()(const pg8::f32x4 (&acc)[2][2][4][2], const pg8::Unit& u, int wr, int wc, int fr, int fq) const {
        const int row0 = u.pm * 256 + wr * 64 + fr, col0 = u.pn * 256 + wc * 32 + 8 * fq;
#pragma unroll
        for (int ai = 0; ai < 2; ++ai)
#pragma unroll
            for (int m = 0; m < 4; ++m) { bf16* rowp = O + (size_t)(row0 + ai * 128 + m * 16) * ldc + col0;
#pragma unroll
                for (int bj = 0; bj < 2; ++bj) { const f32x4 v0 = acc[ai][bj][m][0], v1 = acc[ai][bj][m][1];
                    u32x4 w; w.x = pk2(v0[0], v0[1]); w.y = pk2(v0[2], v0[3]); w.z = pk2(v1[0], v1[1]); w.w = pk2(v1[2], v1[3]);
                    *(u32x4*)(rowp + bj * 128) = w; } }
    }
};
struct Ctx { LAS unsigned char* lds; int tid, lane, wave, q, l15, gw, ngw; unsigned char* ws; };

DI void tr_item(const float* W, int K, int N, bf16* WT, int mode, LAS float* scr  , int item, int lane) {
    const int nblk = N / 32, kb = item / nblk, nb = item % nblk, k0 = 128 * kb, n0 = 32 * nb;
    { const int kr = lane >> 3, n4 = (lane & 7) * 4; f32x4 v[16];
#pragma unroll
      for (int i = 0; i < 16; ++i) v[i] = *(const f32x4*)(W + (size_t)(k0 + 8 * i + kr) * N + n0 + n4);
#pragma unroll
      for (int i = 0; i < 16; ++i) { LAS float* d = scr + (8 * i + kr) * 33 + n4; d[0] = v[i][0]; d[1] = v[i][1]; d[2] = v[i][2]; d[3] = v[i][3]; } }
    asm volatile("s_waitcnt lgkmcnt(0)" ::: "memory");
    int d0 = n0;
    if (mode == 1) d0 = n0 < 3072 ? n0 : (n0 < 3104 ? 6144 + (n0 - 3072) : n0 - 32);
    else if (mode == 2) d0 = (n0 / 128) * 256 + (n0 % 128);
    else if (mode == 3) d0 = (n0 / 128) * 256 + 128 + (n0 % 128);
    const int c = lane & 15;
#pragma unroll
    for (int j = 0; j < 8; ++j) { const int n = (lane >> 4) + 4 * j; const LAS float* s = scr + (8 * c) * 33 + n;
        u32x4 o; o.x = pk2(s[0 * 33], s[1 * 33]); o.y = pk2(s[2 * 33], s[3 * 33]); o.z = pk2(s[4 * 33], s[5 * 33]); o.w = pk2(s[6 * 33], s[7 * 33]);
        *(u32x4*)(WT + (size_t)(d0 + n) * K + k0 + 8 * c) = o; }
    asm volatile("s_waitcnt lgkmcnt(0)" ::: "memory");
}
DI void convert_group(const Ctx& X, int grp, int idx, int stride) {
    unsigned char* const wsl = (unsigned char*)inp(29);
    LAS float* scr = (LAS float*)(X.lds + X.wave * 16896);
    constexpr int I_IN0 = 16 * 193, I_SQ = 16 * 64, I_UP = 16 * 176, I_DN = 44 * 64, I_IN1 = 16 * 192;
    if (grp == 0) {
        for (int it = idx; it < I_IN0; it += stride) tr_item(inp(12), 2048, 6176, (bf16*)(wsl + WS_WIN0), 1, scr, it, X.lane);
    } else if (grp == 1) {
        for (int it = idx; it < I_SQ + 2 * I_UP + I_DN; it += stride) { int r = it;
            if (r < I_SQ) { tr_item(inp(24), 2048, 2048, (bf16*)(wsl + WS_WOUT0), 0, scr, r, X.lane); continue; } r -= I_SQ;
            if (r < I_UP) { tr_item(inp(9), 2048, DFF, (bf16*)(wsl + WS_WUP0), 2, scr, r, X.lane); continue; } r -= I_UP;
            if (r < I_UP) { tr_item(inp(10), 2048, DFF, (bf16*)(wsl + WS_WUP0), 3, scr, r, X.lane); continue; } r -= I_UP;
            tr_item(inp(11), DFF, 2048, (bf16*)(wsl + WS_WDN0), 0, scr, r, X.lane); }
    } else if (grp == 2) {
        for (int it = idx; it < I_IN1 + I_SQ; it += stride) { int r = it;
            if (r < I_IN1) { tr_item(inp(25), 2048, 6144, (bf16*)(wsl + WS_WIN1), 0, scr, r, X.lane); continue; } r -= I_IN1;
            tr_item(inp(27), 2048, 2048, (bf16*)(wsl + WS_WOUT1), 0, scr, r, X.lane); }
    } else {
        for (int it = idx; it < 2 * I_UP + I_DN; it += stride) { int r = it;
            if (r < I_UP) { tr_item(inp(9) + (size_t)2048 * DFF, 2048, DFF, (bf16*)(wsl + WS_WUP1), 2, scr, r, X.lane); continue; } r -= I_UP;
            if (r < I_UP) { tr_item(inp(10) + (size_t)2048 * DFF, 2048, DFF, (bf16*)(wsl + WS_WUP1), 3, scr, r, X.lane); continue; } r -= I_UP;
            tr_item(inp(11) + (size_t)2048 * DFF, DFF, 2048, (bf16*)(wsl + WS_WDN1), 0, scr, r, X.lane); }
    }
}
DI void convert_by_light(const Ctx& X, int grp, int first) {
    const int G = (int)gridDim.x; if (first < 0 || first >= G) first = 0;
    if ((int)blockIdx.x >= first) convert_group(X, grp, ((int)blockIdx.x - first) * 8 + X.wave, (G - first) * 8);
}
DI void adaln_layer(const Ctx& X, int l, int first) {
    unsigned char* const wsl = (unsigned char*)inp(29);
    LAS float* cond = (LAS float*)X.lds;
    LAS float* red = (LAS float*)(X.lds + 40960);
    float* MOD = (float*)(wsl + WS_MOD);
    const int G = (int)gridDim.x; if (first < 0 || first >= G) first = 0;
    if ((int)blockIdx.x < first) return;
    for (int i = X.tid; i < 5 * 2048; i += 512) { const float v = i < 8192 ? inp(1)[i] : inp(3)[i - 8192]; cond[i] = silu_f(v); }
    __syncthreads();
    for (int it = (int)blockIdx.x - first; it < 384; it += G - first) {
        const int n0 = it * 32, cq = X.tid & 7, ks = X.tid >> 3;
        const float* W = inp(4) + (size_t)l * 2048 * 12288 + n0 + 4 * cq;
        float acc[5][4];
#pragma unroll
        for (int r = 0; r < 5; ++r)
#pragma unroll
            for (int j = 0; j < 4; ++j) acc[r][j] = 0.f;
#pragma unroll 8
        for (int kk = 0; kk < 32; ++kk) { const int k = ks * 32 + kk; const f32x4 w = *(const f32x4*)(W + (size_t)k * 12288);
#pragma unroll
            for (int r = 0; r < 5; ++r) { const float cv = cond[r * 2048 + k];
#pragma unroll
                for (int j = 0; j < 4; ++j) acc[r][j] += cv * w[j]; } }
#pragma unroll
        for (int r = 0; r < 5; ++r)
#pragma unroll
            for (int j = 0; j < 4; ++j) red[X.tid * 20 + r * 4 + j] = acc[r][j];
        __syncthreads();
        for (int o = X.tid; o < 160; o += 512) { const int r = o / 32, cc = o % 32, cq2 = cc >> 2, ci = cc & 3; float s = 0.f;
            for (int k2 = 0; k2 < 64; ++k2) s += red[(k2 * 8 + cq2) * 20 + r * 4 + ci];
            MOD[(size_t)(l * 5 + r) * 12288 + n0 + cc] = s + inp(5)[l * 12288 + n0 + cc]; }
        __syncthreads();
    }
}
DI void p0_phase(const Args& a, const Ctx& X) {
    unsigned char* const wsl = (unsigned char*)inp(29);
    adaln_layer(X, 0, 0);
    __syncthreads();
    convert_group(X, 0, X.gw, X.ngw);
    { u32x4* z = (u32x4*)(wsl + WS_WIN0 + (size_t)6176 * 2048 * 2); const u32x4 zero = {0u, 0u, 0u, 0u};
      for (int i = blockIdx.x * 512 + X.tid; i < 224 * 2048 * 2 / 16; i += gridDim.x * 512) z[i] = zero; }
}

DI void norm_mod_phase(const Ctx& X, const float* srcA, const float* srcB, const float* g, const float* mod, int shoff, int scoff, bf16* H, int row_lo, int row_hi, const float* part = nullptr) {
    int row = row_lo + X.gw; f32x4 nv[8];
    if (row < row_hi) { const float* xr0 = row < CROWS ? srcA + (size_t)row * DM : srcB + (size_t)(row - CROWS) * DM;
#pragma unroll
        for (int j = 0; j < 8; ++j) nv[j] = ((const f32x4*)xr0)[X.lane + 64 * j]; }
    for (; row < row_hi; row += X.ngw) {
        const float* xr = row < CROWS ? srcA + (size_t)row * DM : srcB + (size_t)(row - CROWS) * DM;
        const int brow = row_batch(row); const float* sh = mod + (size_t)brow * 12288 + shoff; const float* sc = mod + (size_t)brow * 12288 + scoff;
        f32x4 v[8]; float s = 0.f;
#pragma unroll
        for (int j = 0; j < 8; ++j) v[j] = nv[j];
        { const int nrow = row + X.ngw; if (nrow < row_hi) { const float* xn = nrow < CROWS ? srcA + (size_t)nrow * DM : srcB + (size_t)(nrow - CROWS) * DM;
#pragma unroll
            for (int j = 0; j < 8; ++j) nv[j] = ((const f32x4*)xn)[X.lane + 64 * j]; } }
        if (part != nullptr && row < CROWS) {
#pragma unroll
            for (int j = 0; j < 8; ++j) {
#pragma unroll
                for (int ks = 0; ks < 4; ++ks) v[j] += ((const f32x4*)(part + ((size_t)ks * CROWS + row) * DM))[X.lane + 64 * j];
                ((f32x4*)xr)[X.lane + 64 * j] = v[j]; }
        }
#pragma unroll
        for (int j = 0; j < 8; ++j) s += (v[j][0] * v[j][0] + v[j][1] * v[j][1]) + (v[j][2] * v[j][2] + v[j][3] * v[j][3]);
        s = wave_sum(s); const float rstd = 1.f / sqrtf(s * (1.f / DM) + EPS);
#pragma unroll
        for (int j = 0; j < 8; ++j) { const int c4 = X.lane + 64 * j; const f32x4 gg = ((const f32x4*)g)[c4], sv = ((const f32x4*)sc)[c4], hv = ((const f32x4*)sh)[c4];
            f32x4 o; for (int e = 0; e < 4; ++e) o[e] = v[j][e] * rstd * gg[e] * (1.f + sv[e]) + hv[e];
            u32x2 w; w.x = pk2(o[0], o[1]); w.y = pk2(o[2], o[3]); ((u32x2*)(H + (size_t)row * DM))[c4] = w; }
    }
}

DI void post_phase(const Args& a, const Ctx& X) {
    unsigned char* const wsl = (unsigned char*)inp(29);
    LAS float* cs = (LAS float*)X.lds;
    for (int i = X.tid; i < 1024; i += 512) { const int p = i >> 4, j = i & 15; const float inv = powf(10000.f, -(float)j / 16.f); const float ang = (float)p * inv; cs[i] = cosf(ang); cs[1024 + i] = sinf(ang); }
    __syncthreads();
    const bf16* ZX = (const bf16*)(wsl + WS_BIG); const float* DTRAW = (const float*)(wsl + WS_V); bf16* XBC = (bf16*)(wsl + WS_XBC); bf16* QK = (bf16*)(wsl + WS_QK); float* DT = (float*)(wsl + WS_DT);
    const float* cw = inp(13); const float* cb = inp(14); const float* dtb = inp(16);
    for (int item = X.gw; item < (MROWS / 4) * 8; item += X.ngw) {
        const int rg = item >> 3, j = item & 7, row0 = 4 * rg; const bool isctx = row0 < CROWS; const int t0 = isctx ? (row0 & 255) : ((row0 - CROWS) & 2047); const int seg = isctx ? 256 : 2048;
        const int ch = 4 * X.lane + 256 * j; const bf16* zr0 = ZX + (size_t)row0 * ZXP + 1024 + ch; f32x4 xin[8];
#pragma unroll
        for (int i = 0; i < 8; ++i) { const int tt = t0 + i - 2; xin[i] = (tt >= 0 && tt < seg) ? bf4_to_f32(*(const u32x2*)(zr0 + (ptrdiff_t)(i - 2) * ZXP)) : (f32x4){0.f, 0.f, 0.f, 0.f}; }
        f32x4 wv[5];
#pragma unroll
        for (int tap = 0; tap < 5; ++tap) wv[tap] = *(const f32x4*)(cw + tap * 2048 + ch);
        const f32x4 bv = *(const f32x4*)(cb + ch);
#pragma unroll
        for (int r = 0; r < 4; ++r) { f32x4 acc = bv;
#pragma unroll
            for (int tap = 0; tap < 5; ++tap) acc += wv[tap] * xin[r + tap];
            u32x2 w; w.x = pk2(silu_f(acc[0]), silu_f(acc[1])); w.y = pk2(silu_f(acc[2]), silu_f(acc[3])); *(u32x2*)(XBC + (size_t)(row0 + r) * 2048 + ch) = w; }
    }
    for (int row = X.gw; row < MROWS; row += X.ngw) {
        const bool isctx = row < CROWS; const int t = isctx ? (row & 255) : ((row - CROWS) & 2047); const bf16* zr = ZX + (size_t)row * ZXP;
        if (X.lane < 32) { const float v = DTRAW[(size_t)row * 32 + X.lane] + dtb[X.lane]; DT[(size_t)row * 32 + X.lane] = v > 20.f ? v : log1pf(expf(v)); }
        { const int bi = X.lane; const bf16* src = zr + 3072 + 32 * bi; f32x4 u1[4], u2[4];
#pragma unroll
          for (int j = 0; j < 4; ++j) { u1[j] = bf4_to_f32(*(const u32x2*)(src + 4 * j)); u2[j] = bf4_to_f32(*(const u32x2*)(src + 16 + 4 * j)); }
          const float scl = bi < 32 ? 0.125f * LOG2E : 1.f;
          const int p = (bi & 1) ? (t & 63) : (t >> 6);
          f32x4 o1[4], o2[4];
#pragma unroll
          for (int j = 0; j < 4; ++j) { f32x4 cv = {1.f, 1.f, 1.f, 1.f}, sv = {0.f, 0.f, 0.f, 0.f};
              if (!isctx) { cv = *(const LAS f32x4*)(cs + p * 16 + 4 * j); sv = *(const LAS f32x4*)(cs + 1024 + p * 16 + 4 * j); }
              o1[j] = (u1[j] * cv - u2[j] * sv) * scl; o2[j] = (u1[j] * sv + u2[j] * cv) * scl; }
          bf16* dst = QK + (size_t)row * 2048 + 32 * bi;
          *(bf16x8*)dst = pack8(o1[0], o1[1]); *(bf16x8*)(dst + 8) = pack8(o1[2], o1[3]); *(bf16x8*)(dst + 16) = pack8(o2[0], o2[1]); *(bf16x8*)(dst + 24) = pack8(o2[2], o2[3]); }
    }
}

DI void s1_phase(const Args& a, const Ctx& X) {
    unsigned char* const wsl = (unsigned char*)inp(29);
    LAS bf16* BmT = (LAS bf16*)X.lds; LAS bf16* XT = (LAS bf16*)(X.lds + 34816); LAS float* wgt = (LAS float*)(X.lds + 104448);
    const bf16* XBC = (const bf16*)(wsl + WS_XBC); const float* DT = (const float*)(wsl + WS_DT);
    float* ACUM = (float*)(wsl + WS_ACUM); float* DEC = (float*)(wsl + WS_DEC); float* SST = (float*)(wsl + WS_XRES);
    for (int it = blockIdx.x; it < 288; it += gridDim.x) {
        const int b = it / 72, c = (it >> 2) % 18, g = it & 3, r0 = chunk_row(b, c);
        { const int hh = X.wave & 3, dir = X.wave >> 2, h = 4 * g + hh; const float av = -expf(inp(15)[dir * 16 + h]);
          const float d0 = DT[(size_t)(r0 + 2 * X.lane) * 32 + dir * 16 + h], d1 = DT[(size_t)(r0 + 2 * X.lane + 1) * 32 + dir * 16 + h];
          const float v0 = d0 * av, v1 = d1 * av, ps = v0 + v1; float inc = ps;
#pragma unroll
          for (int o = 1; o < 64; o <<= 1) { const float tv = __shfl_up(inc, o); if (X.lane >= o) inc += tv; }
          const float tot = __shfl(inc, 63), exc = inc - ps;
          float a0, a1; if (dir == 0) { a0 = exc + v0; a1 = inc; } else { a0 = tot - exc; a1 = tot - exc - v0; }
          const size_t idx = ((size_t)((b * 18 + c) * 16 + h)) * 2 + dir;
          ACUM[idx * 128 + 2 * X.lane] = a0; ACUM[idx * 128 + 2 * X.lane + 1] = a1;
          wgt[(hh * 2 + dir) * 128 + 2 * X.lane] = d0 * expf(tot - a0); wgt[(hh * 2 + dir) * 128 + 2 * X.lane + 1] = d1 * expf(tot - a1);
          if (X.lane == 0) DEC[idx] = expf(tot); }
        stage_T<128, 128>(BmT, 136, XBC + (size_t)r0 * 2048 + 1024 + g * 128, 2048, X.tid);
#pragma unroll
        for (int hh = 0; hh < 4; ++hh) stage_T<128, 64>(XT + hh * 64 * 136, 136, XBC + (size_t)r0 * 2048 + (4 * g + hh) * 64, 2048, X.tid);
        __syncthreads();
        bf16x8 bfr[4];
#pragma unroll
        for (int ks = 0; ks < 4; ++ks) bfr[ks] = lds_frag16(BmT + (16 * X.wave + X.l15) * 136 + 32 * ks + 8 * X.q);
#pragma unroll 1
        for (int hd = 0; hd < 8; ++hd) { const int hh = hd >> 1, dir = hd & 1;
            f32x4 acc[4];
#pragma unroll
            for (int pt = 0; pt < 4; ++pt) acc[pt] = (f32x4){0.f, 0.f, 0.f, 0.f};
#pragma unroll
            for (int ks = 0; ks < 4; ++ks) { const LAS float* wp = wgt + hd * 128 + 32 * ks + 8 * X.q; const f32x4 w0 = *(const LAS f32x4*)wp, w1 = *(const LAS f32x4*)(wp + 4);
#pragma unroll
                for (int pt = 0; pt < 4; ++pt) { const bf16x8 xa = lds_frag16(XT + (hh * 64 + 16 * pt + X.l15) * 136 + 32 * ks + 8 * X.q);
                    f32x4 f0, f1;
#pragma unroll
                    for (int j = 0; j < 4; ++j) { f0[j] = bf2f((unsigned short)xa[j]) * w0[j]; f1[j] = bf2f((unsigned short)xa[4 + j]) * w1[j]; }
                    acc[pt] = mfma16(pack8(f0, f1), bfr[ks], acc[pt]); } }
            const size_t idx = ((size_t)((b * 18 + c) * 16 + 4 * g + hh)) * 2 + dir; float* Sp = SST + idx * 8192;
#pragma unroll
            for (int pt = 0; pt < 4; ++pt)
#pragma unroll
                for (int i = 0; i < 4; ++i) Sp[(16 * pt + 4 * X.q + i) * 128 + 16 * X.wave + X.l15] = acc[pt][i];
        }
        __syncthreads();
    }
}
DI void s2_phase(const Ctx& X) {
    unsigned char* const wsl = (unsigned char*)inp(29);
    const float* DEC = (const float*)(wsl + WS_DEC); const float* SST = (const float*)(wsl + WS_XRES); bf16* HIN = (bf16*)(wsl + WS_HIN);
    for (int e = blockIdx.x * 512 + X.tid; e < 4 * 16 * 2 * 8192; e += gridDim.x * 512) {
        const int pn = e & 8191, dir = (e >> 13) & 1, h = (e >> 14) & 15, b = e >> 18; float hc = 0.f;
#pragma unroll
        for (int i = 0; i < 18; ++i) { const int c = dir == 0 ? i : (i < 2 ? 1 - i : 19 - i); const size_t idx = ((size_t)((b * 18 + c) * 16 + h)) * 2 + dir;
            HIN[idx * 8192 + pn] = (bf16)f2bf(hc); hc = hc * DEC[idx] + SST[idx * 8192 + pn]; }
    }
}
typedef short s16x4 __attribute__((ext_vector_type(4)));
DI bf16x8 lds_tr_frag(const LAS bf16* p0, const LAS bf16* p1) {
    const s16x4 a = __builtin_amdgcn_ds_read_tr16_b64_v4i16((LAS s16x4*)p0), b = __builtin_amdgcn_ds_read_tr16_b64_v4i16((LAS s16x4*)p1);
    return __builtin_shufflevector(a, b, 0, 1, 2, 3, 4, 5, 6, 7); }
DI void softmax_tile(f32x4 (&s)[4], float& m, float& lsum, f32x4 (&o)[8], bf16x8 (&pf)[2]) {
    float mx = -3.0e38f;
#pragma unroll
    for (int mt = 0; mt < 4; ++mt)
#pragma unroll
        for (int i = 0; i < 4; ++i) mx = fmaxf(mx, s[mt][i]);
    mx = fmaxf(mx, __shfl_xor(mx, 16)); mx = fmaxf(mx, __shfl_xor(mx, 32));
    if (__builtin_amdgcn_ballot_w64(mx - m > 6.0f) != 0ull) {
        const float mn = fmaxf(m, mx), alpha = __builtin_amdgcn_exp2f(m - mn); m = mn; lsum *= alpha;
#pragma unroll
        for (int dt = 0; dt < 8; ++dt) o[dt] *= alpha;
    }
    float ps = 0.f;
#pragma unroll
    for (int mt = 0; mt < 4; ++mt)
#pragma unroll
        for (int i = 0; i < 4; ++i) { const float p = __builtin_amdgcn_exp2f(s[mt][i] - m); s[mt][i] = p; ps += p; }
    lsum += ps;
    pf[0] = pack8(s[0], s[1]); pf[1] = pack8(s[2], s[3]);
}
DI void pv_tile(const LAS bf16* vb, const bf16x8 (&pf0)[2], const bf16x8 (&pf1)[2], f32x4 (&o0)[8], f32x4 (&o1)[8]) {
#pragma unroll
    for (int kk = 0; kk < 2; ++kk)
#pragma unroll
        for (int dt = 0; dt < 8; ++dt) { const bf16x8 vf = lds_tr_frag(vb + (32 * kk) * 144 + 16 * dt, vb + (32 * kk + 16) * 144 + 16 * dt);
            o0[dt] = mfma16(vf, pf0[kk], o0[dt]); o1[dt] = mfma16(vf, pf1[kk], o1[dt]); }
}

DI void s3_item(const Args& a, const Ctx& X, int it) {
    unsigned char* const wsl = (unsigned char*)inp(29);
    LAS bf16* Cm = (LAS bf16*)X.lds; LAS bf16* Bm = (LAS bf16*)(X.lds + 34816); LAS bf16* XT = (LAS bf16*)(X.lds + 69632);
    LAS bf16* Hf = (LAS bf16*)(X.lds + 87040); LAS bf16* Gb = (LAS bf16*)(X.lds + 104448);
    LAS float* acf = (LAS float*)(X.lds + 121856); LAS float* acb = acf + 512; LAS float* dtf = acf + 1024; LAS float* dtb = acf + 1536;
    const bf16* XBC = (const bf16*)(wsl + WS_XBC); const float* DT = (const float*)(wsl + WS_DT); const float* ACUM = (const float*)(wsl + WS_ACUM);
    const bf16* HIN = (const bf16*)(wsl + WS_HIN); const bf16* ZX = (const bf16*)(wsl + WS_BIG); bf16* MIX = (bf16*)(wsl + WS_MIX);
    const int b = it / 72, c = (it >> 2) % 18, g = it & 3, r0 = chunk_row(b, c);
    __syncthreads();
    stage_N<128, 128>(Cm, 136, XBC + (size_t)r0 * 2048 + 1536 + g * 128, 2048, X.tid);
    stage_N<128, 128>(Bm, 136, XBC + (size_t)r0 * 2048 + 1024 + g * 128, 2048, X.tid);
    { const int hh = X.tid >> 7, l = X.tid & 127, h = 4 * g + hh; const size_t idx0 = ((size_t)((b * 18 + c) * 16 + h)) * 2;
      acf[hh * 128 + l] = ACUM[idx0 * 128 + l]; acb[hh * 128 + l] = ACUM[(idx0 + 1) * 128 + l];
      dtf[hh * 128 + l] = DT[(size_t)(r0 + l) * 32 + h]; dtb[hh * 128 + l] = DT[(size_t)(r0 + l) * 32 + 16 + h]; }
    __syncthreads();
    const int myl = 16 * X.wave + X.l15;
    bf16x8 cfr[4];
#pragma unroll
    for (int ks = 0; ks < 4; ++ks) cfr[ks] = lds_frag16(Cm + myl * 136 + 32 * ks + 8 * X.q);
    f32x4* USCR = (f32x4*)(wsl + WS_USCR) + (size_t)blockIdx.x * 8192;
    float ss = 0.f;
    const int xr_ = X.tid & 127, xc_ = X.tid >> 7, nr_ = X.tid >> 4, nc_ = (X.tid & 15) * 8;
    u32x4 px0, px1, ph0, ph1, pg0, pg1;
#define S3_LOAD(hh_) do { const int h_ = 4 * g + (hh_); const size_t i0_ = ((size_t)((b * 18 + c) * 16 + h_)) * 2; const bf16* xs_ = XBC + (size_t)(r0 + xr_) * 2048 + h_ * 64; \
        px0 = *(const u32x4*)(xs_ + xc_ * 8); px1 = *(const u32x4*)(xs_ + (xc_ + 4) * 8); \
        ph0 = *(const u32x4*)(HIN + i0_ * 8192 + (size_t)nr_ * 128 + nc_); ph1 = *(const u32x4*)(HIN + i0_ * 8192 + (size_t)(nr_ + 32) * 128 + nc_); \
        pg0 = *(const u32x4*)(HIN + (i0_ + 1) * 8192 + (size_t)nr_ * 128 + nc_); pg1 = *(const u32x4*)(HIN + (i0_ + 1) * 8192 + (size_t)(nr_ + 32) * 128 + nc_); } while (0)
#define S3_PUT_T(v_, c8_) do { LAS bf16* d_ = XT + ((c8_) * 8) * 136 + xr_; d_[0] = (bf16)((v_).x & 0xffffu); d_[136] = (bf16)((v_).x >> 16); d_[2 * 136] = (bf16)((v_).y & 0xffffu); d_[3 * 136] = (bf16)((v_).y >> 16); \
        d_[4 * 136] = (bf16)((v_).z & 0xffffu); d_[5 * 136] = (bf16)((v_).z >> 16); d_[6 * 136] = (bf16)((v_).w & 0xffffu); d_[7 * 136] = (bf16)((v_).w >> 16); } while (0)
    S3_LOAD(0);
#pragma unroll 1
    for (int hh = 0; hh < 4; ++hh) {
        const int h = 4 * g + hh;
        __syncthreads();
        S3_PUT_T(px0, xc_); S3_PUT_T(px1, xc_ + 4);
        *(LAS u32x4*)(Hf + nr_ * 136 + nc_) = ph0; *(LAS u32x4*)(Hf + (nr_ + 32) * 136 + nc_) = ph1;
        *(LAS u32x4*)(Gb + nr_ * 136 + nc_) = pg0; *(LAS u32x4*)(Gb + (nr_ + 32) * 136 + nc_) = pg1;
        __syncthreads();
        if (hh < 3) S3_LOAD(hh + 1);
        const float afl = acf[hh * 128 + myl], abl = acb[hh * 128 + myl];
        f32x4 yv[4], yf[4], yb[4];
#pragma unroll
        for (int pt = 0; pt < 4; ++pt) { yv[pt] = (f32x4){0.f, 0.f, 0.f, 0.f}; yf[pt] = yv[pt]; yb[pt] = yv[pt]; }
#pragma unroll 1
        for (int kk = 0; kk < 4; ++kk) {
            f32x4 mv[2];
#pragma unroll
            for (int hf = 0; hf < 2; ++hf) { const int st = 2 * kk + hf; f32x4 cb = {0.f, 0.f, 0.f, 0.f};
#pragma unroll
                for (int ks = 0; ks < 4; ++ks) cb = mfma16(lds_frag16(Bm + (16 * st + X.l15) * 136 + 32 * ks + 8 * X.q), cfr[ks], cb);
#pragma unroll
                for (int i = 0; i < 4; ++i) { const int s = 16 * st + 4 * X.q + i;
                    const float ef = __expf(afl - acf[hh * 128 + s]), eb = __expf(abl - acb[hh * 128 + s]);
                    float cf = (s <= myl) ? dtf[hh * 128 + s] * ef : 0.f; cf += (s >= myl) ? dtb[hh * 128 + s] * eb : 0.f;
                    mv[hf][i] = cb[i] * cf; } }
            const bf16x8 mfr = pack8(mv[0], mv[1]);
#pragma unroll
            for (int pt = 0; pt < 4; ++pt) { const LAS bf16* xp = XT + (16 * pt + X.l15) * 136 + 32 * kk + 4 * X.q; yv[pt] = mfma16(lds_frag8x2(xp, xp + 16), mfr, yv[pt]); }
        }
#pragma unroll
        for (int ks = 0; ks < 4; ++ks)
#pragma unroll
            for (int pt = 0; pt < 4; ++pt) { yf[pt] = mfma16(lds_frag16(Hf + (16 * pt + X.l15) * 136 + 32 * ks + 8 * X.q), cfr[ks], yf[pt]);
                yb[pt] = mfma16(lds_frag16(Gb + (16 * pt + X.l15) * 136 + 32 * ks + 8 * X.q), cfr[ks], yb[pt]); }
        const float ef = expf(afl), eb = expf(abl), dsk = inp(17)[h];
#pragma unroll
        for (int pt = 0; pt < 4; ++pt) { const int p0 = 16 * pt + 4 * X.q; const f32x4 zv = bf4_to_f32(*(const u32x2*)(ZX + (size_t)(r0 + myl) * ZXP + h * 64 + p0)); f32x4 uv;
#pragma unroll
            for (int i = 0; i < 4; ++i) { const float xv = bf2f(XT[(p0 + i) * 136 + myl]); const float y = yv[pt][i] + ef * yf[pt][i] + eb * yb[pt][i];
                uv[i] = (y + dsk * xv) * silu_f(zv[i]); ss += uv[i] * uv[i]; }
            USCR[(hh * 4 + pt) * 512 + X.tid] = uv; }
    }
    ss += __shfl_xor(ss, 16); ss += __shfl_xor(ss, 32);
    const float rstd = 1.f / sqrtf(ss * (1.f / 256.f) + EPS);
#pragma unroll 1
    for (int hh = 0; hh < 4; ++hh)
#pragma unroll
        for (int pt = 0; pt < 4; ++pt) { const int ch = g * 256 + hh * 64 + 16 * pt + 4 * X.q; const f32x4 gg = *(const f32x4*)(inp(18) + ch); const f32x4 uv = USCR[(hh * 4 + pt) * 512 + X.tid];
            u32x2 w; w.x = pk2(uv[0] * rstd * gg[0], uv[1] * rstd * gg[1]); w.y = pk2(uv[2] * rstd * gg[2], uv[3] * rstd * gg[3]);
            *(u32x2*)(MIX + (size_t)(r0 + myl) * 2048 + ch) = w; }
}

#undef S3_LOAD
#undef S3_PUT_T
DI void da_item(const Args& a, const Ctx& X, int it, float lam) {
    unsigned char* const wsl = (unsigned char*)inp(29);
    LAS bf16* KS = (LAS bf16*)X.lds; LAS bf16* VS = (LAS bf16*)(X.lds + 18432); LAS float* EX = (LAS float*)(X.lds + 36864);
    const bf16* QK = (const bf16*)(wsl + WS_QK); const bf16* V = (const bf16*)(wsl + WS_BIG) + 5120; bf16* MIX = (bf16*)(wsl + WS_MIX);
    int b, hp, qb; const bool lat = it < 512;
    if (lat) { b = it >> 7; hp = (it >> 4) & 7; qb = it & 15; } else { const int j = it - 512; b = j >> 4; hp = (j >> 1) & 7; qb = j & 1; }
    const int q0row = lat ? CROWS + b * 2048 + qb * 128 : b * 256 + qb * 128, nkt = lat ? 36 : 4;
    const int e = X.wave & 1, qg = X.wave >> 1;
    bf16x8 qf[2][2];
#pragma unroll
    for (int qt = 0; qt < 2; ++qt)
#pragma unroll
        for (int ks = 0; ks < 2; ++ks) qf[qt][ks] = *(const bf16x8*)(QK + (size_t)(q0row + 32 * qg + 16 * qt + X.l15) * 2048 + (2 * hp + e) * 64 + 32 * ks + 8 * X.q);
    f32x4 o0[8], o1[8];
#pragma unroll
    for (int dt = 0; dt < 8; ++dt) { o0[dt] = (f32x4){0.f, 0.f, 0.f, 0.f}; o1[dt] = o0[dt]; }
    float m0 = -1.0e30f, m1 = -1.0e30f, l0 = 0.f, l1 = 0.f;
    const LAS bf16* kb = KS + e * 64 * 72 + X.l15 * 72 + 8 * X.q;
    const LAS bf16* vb = VS + (4 * X.q + (X.l15 >> 2)) * 144 + 4 * (X.lane & 3);
    const int kr = X.tid >> 3, kc = (X.tid & 7) * 8, vr = X.tid >> 4, vc = (X.tid & 15) * 8;
    u32x4 pk0, pk1, pv0, pv1;
#define DA_LOAD(kt_) do { const int kr0_ = (kt_) < 4 ? b * 256 + 64 * (kt_) : CROWS + b * 2048 + 64 * ((kt_) - 4); \
        pk0 = *(const u32x4*)(QK + (size_t)(kr0_ + kr) * 2048 + 1024 + (2 * hp) * 64 + kc); pk1 = *(const u32x4*)(QK + (size_t)(kr0_ + kr) * 2048 + 1024 + (2 * hp + 1) * 64 + kc); \
        pv0 = *(const u32x4*)(V + (size_t)(kr0_ + vr) * ZXP + hp * 128 + vc); pv1 = *(const u32x4*)(V + (size_t)(kr0_ + 32 + vr) * ZXP + hp * 128 + vc); } while (0)
    DA_LOAD(0);
    for (int kt = 0; kt < nkt; ++kt) {
        __syncthreads();
        *(LAS u32x4*)(KS + kr * 72 + kc) = pk0; *(LAS u32x4*)(KS + 64 * 72 + kr * 72 + kc) = pk1;
        *(LAS u32x4*)(VS + vr * 144 + vc) = pv0; *(LAS u32x4*)(VS + (32 + vr) * 144 + vc) = pv1;
        __syncthreads();
        if (kt + 1 < nkt) DA_LOAD(kt + 1);
        bf16x8 pf0[2], pf1[2];
        { f32x4 s0[4], s1[4];
#pragma unroll
          for (int mt = 0; mt < 4; ++mt) { s0[mt] = (f32x4){0.f, 0.f, 0.f, 0.f}; s1[mt] = s0[mt];
#pragma unroll
              for (int ks = 0; ks < 2; ++ks) { const bf16x8 kf = lds_frag16(kb + 16 * mt * 72 + 32 * ks); s0[mt] = mfma16(kf, qf[0][ks], s0[mt]); s1[mt] = mfma16(kf, qf[1][ks], s1[mt]); } }
          softmax_tile(s0, m0, l0, o0, pf0); softmax_tile(s1, m1, l1, o1, pf1); }
        pv_tile(vb, pf0, pf1, o0, o1);
    }
#undef DA_LOAD
    l0 += __shfl_xor(l0, 16); l0 += __shfl_xor(l0, 32); l1 += __shfl_xor(l1, 16); l1 += __shfl_xor(l1, 32);
    __syncthreads();
    if (e == 1) { const float i0 = lam / l0, i1 = lam / l1;
#pragma unroll
        for (int dt = 0; dt < 8; ++dt) { *(LAS f32x4*)(EX + (32 * qg + X.l15) * 132 + 16 * dt + 4 * X.q) = o0[dt] * i0; *(LAS f32x4*)(EX + (32 * qg + 16 + X.l15) * 132 + 16 * dt + 4 * X.q) = o1[dt] * i1; } }
    __syncthreads();
    if (e == 0) { const float i0 = 1.f / l0, i1 = 1.f / l1; float ss0 = 0.f, ss1 = 0.f;
#pragma unroll
        for (int dt = 0; dt < 8; ++dt) { const f32x4 x0 = *(const LAS f32x4*)(EX + (32 * qg + X.l15) * 132 + 16 * dt + 4 * X.q), x1 = *(const LAS f32x4*)(EX + (32 * qg + 16 + X.l15) * 132 + 16 * dt + 4 * X.q);
            o0[dt] = o0[dt] * i0 - x0; o1[dt] = o1[dt] * i1 - x1;
#pragma unroll
            for (int i = 0; i < 4; ++i) { ss0 += o0[dt][i] * o0[dt][i]; ss1 += o1[dt][i] * o1[dt][i]; } }
        ss0 += __shfl_xor(ss0, 16); ss0 += __shfl_xor(ss0, 32); ss1 += __shfl_xor(ss1, 16); ss1 += __shfl_xor(ss1, 32);
        const float r0 = 0.8f / sqrtf(ss0 * (1.f / 128.f) + EPS), r1 = 0.8f / sqrtf(ss1 * (1.f / 128.f) + EPS);
        const float* sg = inp(23);
#pragma unroll
        for (int dt = 0; dt < 8; ++dt) { const int d = 16 * dt + 4 * X.q; const f32x4 gg = *(const f32x4*)(sg + d);
            u32x2 w; w.x = pk2(o0[dt][0] * r0 * gg[0], o0[dt][1] * r0 * gg[1]); w.y = pk2(o0[dt][2] * r0 * gg[2], o0[dt][3] * r0 * gg[3]);
            *(u32x2*)(MIX + (size_t)(q0row + 32 * qg + X.l15) * 2048 + 1024 + hp * 128 + d) = w;
            w.x = pk2(o1[dt][0] * r1 * gg[0], o1[dt][1] * r1 * gg[1]); w.y = pk2(o1[dt][2] * r1 * gg[2], o1[dt][3] * r1 * gg[3]);
            *(u32x2*)(MIX + (size_t)(q0row + 32 * qg + 16 + X.l15) * 2048 + 1024 + hp * 128 + d) = w; } }
}

DI void na_item(const Args& a, const Ctx& X, int it) {
    unsigned char* const wsl = (unsigned char*)inp(29);
    LAS bf16* KS = (LAS bf16*)X.lds; LAS bf16* VS = (LAS bf16*)(X.lds + 17408); LAS float* rpbL = (LAS float*)(X.lds + 35840);
    const bf16* QKV = (const bf16*)(wsl + WS_BIG); bf16* MIX = (bf16*)(wsl + WS_MIX);
    const int b = it >> 7, head = (it >> 3) & 15, rq = it & 7, r = 4 * rq + (X.wave >> 1), chalf = X.wave & 1;
    const int rs = min(max(r - 4, 0), 24), rs_lo = min(max(4 * rq - 4, 0), 24), rs_hi = min(max(4 * rq - 1, 0), 24) + 7, nwin = rs_hi - rs_lo + 1;
    const int qc0 = 32 * chalf + X.l15, qc1 = qc0 + 16, cs0 = min(max(qc0 - 8, 0), 48), cs1 = min(max(qc1 - 8, 0), 48);
    const int qrow0 = CROWS + b * 2048 + r * 64 + qc0;
    __syncthreads();
    { const float* rp = inp(26) + head * 465; for (int i = X.tid; i < 480; i += 512) { const int rr = i >> 5, cc = i & 31; rpbL[i] = cc < 31 ? rp[rr * 31 + cc] * LOG2E : -1.0e30f; } }
    unsigned vm0 = 0u, vm1 = 0u; const int db0 = 4 * X.q - qc0 + 15, db1 = 4 * X.q - qc1 + 15;
#pragma unroll
    for (int mt = 0; mt < 4; ++mt)
#pragma unroll
        for (int i = 0; i < 4; ++i) { const int kc = 16 * mt + 4 * X.q + i; vm0 |= (kc >= cs0 && kc < cs0 + 16) ? (1u << (4 * mt + i)) : 0u; vm1 |= (kc >= cs1 && kc < cs1 + 16) ? (1u << (4 * mt + i)) : 0u; }
    bf16x8 qf[2][4];
#pragma unroll
    for (int qt = 0; qt < 2; ++qt)
#pragma unroll
        for (int ks = 0; ks < 4; ++ks) qf[qt][ks] = *(const bf16x8*)(QKV + (size_t)(qrow0 + 16 * qt) * NIN1 + head * 128 + 32 * ks + 8 * X.q);
    f32x4 o0[8], o1[8];
#pragma unroll
    for (int dt = 0; dt < 8; ++dt) { o0[dt] = (f32x4){0.f, 0.f, 0.f, 0.f}; o1[dt] = o0[dt]; }
    float m0 = -1.0e30f, m1 = -1.0e30f, l0 = 0.f, l1 = 0.f; const float SC = 0.08838834764831845f * LOG2E;
    const LAS bf16* kb = KS + X.l15 * 136 + 8 * X.q;
    const LAS bf16* vb = VS + (4 * X.q + (X.l15 >> 2)) * 144 + 4 * (X.lane & 3);
    const int sr = X.tid >> 4, sc = (X.tid & 15) * 8, ntile = nwin + 4;
    u32x4 pk0, pk1, pv0, pv1;
#define NA_LOAD(ti_) do { const int kr0_ = (ti_) < nwin ? CROWS + b * 2048 + (rs_lo + (ti_)) * 64 : b * 256 + 64 * ((ti_) - nwin); const bf16* base_ = QKV + (size_t)(kr0_ + sr) * NIN1 + head * 128 + sc; \
        pk0 = *(const u32x4*)(base_ + 2048); pk1 = *(const u32x4*)(base_ + 2048 + (size_t)32 * NIN1); pv0 = *(const u32x4*)(base_ + 4096); pv1 = *(const u32x4*)(base_ + 4096 + (size_t)32 * NIN1); } while (0)
    NA_LOAD(0);
    for (int ti = 0; ti < ntile; ++ti) {
        const bool win = ti < nwin; const int ur = rs_lo + ti;
        __syncthreads();
        *(LAS u32x4*)(KS + sr * 136 + sc) = pk0; *(LAS u32x4*)(KS + (32 + sr) * 136 + sc) = pk1;
        *(LAS u32x4*)(VS + sr * 144 + sc) = pv0; *(LAS u32x4*)(VS + (32 + sr) * 144 + sc) = pv1;
        __syncthreads();
        if (ti + 1 < ntile) NA_LOAD(ti + 1);
        if (!win || (ur >= rs && ur < rs + 8)) {
            bf16x8 pf0[2], pf1[2]; const int dr = ur - r + 7;
            { f32x4 s0[4], s1[4];
#pragma unroll
              for (int mt = 0; mt < 4; ++mt) { s0[mt] = (f32x4){0.f, 0.f, 0.f, 0.f}; s1[mt] = s0[mt];
#pragma unroll
                  for (int ks = 0; ks < 4; ++ks) { const bf16x8 kf = lds_frag16(kb + 16 * mt * 136 + 32 * ks); s0[mt] = mfma16(kf, qf[0][ks], s0[mt]); s1[mt] = mfma16(kf, qf[1][ks], s1[mt]); } }
              if (win) {
#pragma unroll
                  for (int mt = 0; mt < 4; ++mt)
#pragma unroll
                      for (int i = 0; i < 4; ++i) { const LAS float* rb = rpbL + dr * 32;
                          const int c0 = (vm0 >> (4 * mt + i)) & 1u ? db0 + 16 * mt + i : 31, c1 = (vm1 >> (4 * mt + i)) & 1u ? db1 + 16 * mt + i : 31;
                          s0[mt][i] = s0[mt][i] * SC + rb[c0]; s1[mt][i] = s1[mt][i] * SC + rb[c1]; } }
              else {
#pragma unroll
                  for (int mt = 0; mt < 4; ++mt) { s0[mt] *= SC; s1[mt] *= SC; } }
              softmax_tile(s0, m0, l0, o0, pf0); softmax_tile(s1, m1, l1, o1, pf1); }
            pv_tile(vb, pf0, pf1, o0, o1);
        }
    }
#undef NA_LOAD
    l0 += __shfl_xor(l0, 16); l0 += __shfl_xor(l0, 32); l1 += __shfl_xor(l1, 16); l1 += __shfl_xor(l1, 32);
    const float i0 = 1.f / l0, i1 = 1.f / l1;
#pragma unroll
    for (int dt = 0; dt < 8; ++dt) { const int d = 16 * dt + 4 * X.q;
        u32x2 w; w.x = pk2(o0[dt][0] * i0, o0[dt][1] * i0); w.y = pk2(o0[dt][2] * i0, o0[dt][3] * i0);
        *(u32x2*)(MIX + (size_t)qrow0 * 2048 + head * 128 + d) = w;
        w.x = pk2(o1[dt][0] * i1, o1[dt][1] * i1); w.y = pk2(o1[dt][2] * i1, o1[dt][3] * i1);
        *(u32x2*)(MIX + (size_t)(qrow0 + 16) * 2048 + head * 128 + d) = w; }
}

DI void final_phase(const Args& a, const Ctx& X) {
    unsigned char* const wsl = (unsigned char*)inp(29);
    const float* XR = (const float*)(wsl + WS_XRES); const float* g = inp(8); float* outp = (float*)inp(28);
    int row = CROWS + X.gw; f32x4 nv[8];
    if (row < MROWS) {
#pragma unroll
        for (int j = 0; j < 8; ++j) nv[j] = ((const f32x4*)(XR + (size_t)row * DM))[X.lane + 64 * j]; }
    for (; row < MROWS; row += X.ngw) {
        f32x4 v[8]; float s = 0.f;
#pragma unroll
        for (int j = 0; j < 8; ++j) { v[j] = nv[j]; s += (v[j][0] * v[j][0] + v[j][1] * v[j][1]) + (v[j][2] * v[j][2] + v[j][3] * v[j][3]); }
        { const int nrow = row + X.ngw; if (nrow < MROWS) {
#pragma unroll
            for (int j = 0; j < 8; ++j) nv[j] = ((const f32x4*)(XR + (size_t)nrow * DM))[X.lane + 64 * j]; } }
        s = wave_sum(s); const float rstd = 1.f / sqrtf(s * (1.f / DM) + EPS);
#pragma unroll
        for (int j = 0; j < 8; ++j) { const int c4 = X.lane + 64 * j; const f32x4 gg = ((const f32x4*)g)[c4]; ((f32x4*)(outp + (size_t)(row - CROWS) * DM))[c4] = v[j] * rstd * gg; }
    }
}

#define XB_TMO      128
#define XB_XCNT(j)  (256  + 64 * (j))
#define XB_XSUB(j)  (1280 + 64 * (j))
#define XB_XGEN(j)  (2304 + 64 * (j))
#define XB_TOP      3328
#define XB_TOPGEN   3392
#define XCD_BAR_WORDS 3456
#define XB_SPIN_CAP (1u << 18)

__device__ __forceinline__ unsigned xb_ld(unsigned* p)              { return __hip_atomic_load(p, __ATOMIC_RELAXED, __HIP_MEMORY_SCOPE_AGENT); }
__device__ __forceinline__ unsigned xb_add(unsigned* p, unsigned v) { return __hip_atomic_fetch_add(p, v, __ATOMIC_RELAXED, __HIP_MEMORY_SCOPE_AGENT); }
__device__ __forceinline__ unsigned xb_xcc_id() { return (unsigned)__builtin_amdgcn_s_getreg((3 << 11) | 20) & 0xFu; }
#define XB_SPIN(cond, bar) do { unsigned _sp = 0; while (cond) { __builtin_amdgcn_s_sleep(1); \
    if ((++_sp & 255u) == 0u) { if (xb_ld(&(bar)[XB_TMO])) break; if (_sp > XB_SPIN_CAP) { atomicAdd(&(bar)[XB_TMO], 1u); break; } } } } while (0)

struct XcdBarrier {
    unsigned* bar; unsigned x;
    volatile LAS unsigned* st;
};

__device__ __forceinline__ XcdBarrier xcd_barrier_post(unsigned* bar, volatile LAS unsigned* st) {
    XcdBarrier b; b.bar = bar; b.x = xb_xcc_id(); b.st = st;
    if (threadIdx.x == 0) (void)xb_add(&bar[XB_XCNT(b.x)], 1u);
    return b;
}
__device__ __forceinline__ void xcd_barrier_complete(unsigned* bar, unsigned x, unsigned& nloc, unsigned& nx) {
    const unsigned G = gridDim.x * gridDim.y * gridDim.z;
    unsigned sum, cnt, mine, sp = 0u;
    for (;;) {
        sum = 0u; cnt = 0u; mine = 0u;
#pragma unroll
        for (unsigned j = 0; j < 16; ++j) { const unsigned c = xb_ld(&bar[XB_XCNT(j)]); sum += c; cnt += (c > 0u) ? 1u : 0u; mine = (j == x) ? c : mine; }
        if (sum == G) break;
        __builtin_amdgcn_s_sleep(1);
        if ((++sp & 255u) == 0u) { if (xb_ld(&bar[XB_TMO])) break; if (sp > XB_SPIN_CAP) { atomicAdd(&bar[XB_TMO], 1u); break; } }
    }
    nloc = mine > 0u ? mine : 1u; nx = cnt > 0u ? cnt : 1u;
}

__device__ __forceinline__ void xcd_barrier(const XcdBarrier& b) {
    asm volatile("s_waitcnt vmcnt(0)" ::: "memory");
    __syncthreads();
    if (threadIdx.x == 0) {
        unsigned* bar = b.bar;
        __builtin_amdgcn_s_waitcnt(0);
        unsigned nloc = b.st[0], nx = b.st[1];
        if (nloc == 0u) { xcd_barrier_complete(bar, b.x, nloc, nx); b.st[0] = nloc; b.st[1] = nx; }
        const unsigned old = xb_add(&bar[XB_XSUB(b.x)], 1u);
        const unsigned gen = old / nloc;
        if (old + 1u == (gen + 1u) * nloc) {
            __builtin_amdgcn_fence(__ATOMIC_RELEASE, "agent");
            asm volatile("s_waitcnt vmcnt(0)" ::: "memory");
            const unsigned og = xb_add(&bar[XB_TOP], 1u);
            const unsigned tg = og / nx;
            if (og + 1u == (tg + 1u) * nx) xb_add(&bar[XB_TOPGEN], 1u);
            else XB_SPIN(xb_ld(&bar[XB_TOPGEN]) == tg, bar);
            __builtin_amdgcn_fence(__ATOMIC_ACQUIRE, "agent");
            xb_add(&bar[XB_XGEN(b.x)], 1u);
            asm volatile("s_waitcnt vmcnt(0)" ::: "memory");
        } else {
            XB_SPIN(xb_ld(&bar[XB_XGEN(b.x)]) == gen, bar);
            __builtin_amdgcn_fence(__ATOMIC_ACQUIRE, "agent");
            asm volatile("s_waitcnt vmcnt(0)" ::: "memory");
        }
    }
    __syncthreads();
}

#define WSP(T, off) ((T*)((unsigned char*)inp(29) + (off)))
#define MOD0P WSP(float, WS_MOD)
#define MOD1P (WSP(float, WS_MOD) + 5 * 12288)
#define XRESP WSP(float, WS_XRES)
#define XRESBP (WSP(float, WS_XRES) + (size_t)CROWS * DM)
#ifndef DUPMASK
#define DUPMASK 0u
#endif
#ifndef PH
#define PH 0xFFFFFFFFu
#endif
#define ON(k) if constexpr ((PH >> (k)) & 1u)
#define DUP(k) if constexpr ((DUPMASK >> (k)) & 1u)
DI Ctx mkctx(LAS unsigned char* lds) {
    Ctx X; int t = threadIdx.x; asm volatile("" : "+v"(t)); X.lds = lds; X.tid = t; X.lane = t & 63; X.wave = __builtin_amdgcn_readfirstlane(t >> 6); X.q = X.lane >> 4; X.l15 = X.lane & 15;
    X.gw = blockIdx.x * 8 + X.wave; X.ngw = gridDim.x * 8; X.ws = nullptr; return X; }
template <class Epi> DI void run_gemm(LAS unsigned char* lds, const bf16* A, const bf16* Bt, int M, int N, int K, const Epi& E) {
    pg8::Gemm g{A, Bt, M, N, K}; pg8::StaticOrder S; S.init(M, N, (int)gridDim.x, (int)blockIdx.x); S.ntf = K / 64;
    pg8::gemm_phase<Epi, pg8::StaticOrder, false>(lds, g, S, E, nullptr);
}
struct MixOrder : pg8::StaticOrder {
    __device__ bool next(int i, pg8::Unit& u) const {
        const long L = (long)i * G + c;
        if (L < nwg) { pg8::StaticOrder::next(i, u); u.pm += 4; return true; }
        const int j = (int)(L - nwg); if (j >= 128) return false;
        u.pm = j >> 5; u.pn = (j >> 2) & 7; u.nt = ntf >> 2; u.koff = (j & 3) * u.nt * 128; return true;
    }
};
template <class Epi> DI void run_gemm_mix(LAS unsigned char* lds, const bf16* A, const bf16* Bt, int K, const Epi& E) {
    pg8::Gemm g{A, Bt, MROWS, DM, K}; MixOrder S; S.init(MROWS - CROWS, DM, (int)gridDim.x, (int)blockIdx.x); S.ntf = K / 64;
    pg8::gemm_phase<Epi, MixOrder, false>(lds, g, S, E, nullptr);
}
__global__ void __launch_bounds__(512) fwd_kernel(Args a) {
    extern __shared__ __attribute__((aligned(16))) unsigned char smem[];
    cg::grid_group grid = cg::this_grid();
    LAS unsigned char* const lds = (LAS unsigned char*)smem;
    volatile LAS unsigned* bst = (volatile LAS unsigned*)(lds + LDS_BYTES - 16);
    if (threadIdx.x < 4) bst[threadIdx.x] = 0u;
    __syncthreads();
    if (blockIdx.x == 0) { unsigned* bw = WSP(unsigned, WS_BAR); for (int i = threadIdx.x; i < XCD_BAR_WORDS; i += 512) bw[i] = 0u; }
#define SEAM() xcd_barrier(bar)
    ON(0) { const Ctx X = mkctx(lds); p0_phase(a, X); }
    DUP(0) { __syncthreads(); const Ctx X = mkctx(lds); p0_phase(a, X); }
    grid.sync();
    XcdBarrier bar = xcd_barrier_post(WSP(unsigned, WS_BAR), bst);
    ON(1) { const Ctx X = mkctx(lds); norm_mod_phase(X, inp(2), inp(0), inp(6), MOD0P, 0, 2048, WSP(bf16, WS_H), 0, MROWS); }
    SEAM();
    ON(2) { EpiInProj0 E{WSP(bf16, WS_BIG), WSP(float, WS_V)}; run_gemm(lds, WSP(bf16, WS_H), WSP(const bf16, WS_WIN0), MROWS, NIN0, DM, E); }
    DUP(2) { EpiInProj0 E{WSP(bf16, WS_BIG), WSP(float, WS_V)}; run_gemm(lds, WSP(bf16, WS_H), WSP(const bf16, WS_WIN0), MROWS, NIN0, DM, E); }
    ON(2) { __syncthreads(); const Ctx X = mkctx(lds); convert_by_light(X, 1, (int)(((MROWS / 256) * (NIN0 / 256)) % gridDim.x)); }
    SEAM();
    ON(3) { const Ctx X = mkctx(lds); post_phase(a, X); }
    DUP(3) { __syncthreads(); const Ctx X = mkctx(lds); post_phase(a, X); }
    SEAM();
    ON(4) { const Ctx X = mkctx(lds); s1_phase(a, X); }
    DUP(4) { const Ctx X = mkctx(lds); s1_phase(a, X); }
    SEAM();
    ON(5) { const Ctx X = mkctx(lds); s2_phase(X); }
    DUP(5) { const Ctx X = mkctx(lds); s2_phase(X); }
    SEAM();
    ON(6) { const Ctx X = mkctx(lds); { const f32x4* src = (const f32x4*)inp(2); f32x4* dst = (f32x4*)XRESP; for (int i = blockIdx.x * 512 + X.tid; i < CROWS * DM / 4; i += gridDim.x * 512) dst[i] = src[i]; }
        for (int it = blockIdx.x; it < 288; it += gridDim.x) s3_item(a, X, it); }
    DUP(6) { const Ctx X = mkctx(lds); for (int it = blockIdx.x; it < 288; it += gridDim.x) s3_item(a, X, it); }
    ON(7) { const Ctx X = mkctx(lds); float lam; { const float p1 = inp(19)[X.lane] * inp(20)[X.lane], p2 = inp(21)[X.lane] * inp(22)[X.lane]; lam = expf(wave_sum(p1)) - expf(wave_sum(p2)) + 0.2f; }
        for (int it = blockIdx.x; it < 512; it += gridDim.x) da_item(a, X, it, lam);
        for (int j = (int)((blockIdx.x + 64u) % gridDim.x); j < 64; j += gridDim.x) da_item(a, X, 512 + j, lam);
        __syncthreads(); convert_by_light(X, 2, (int)(288 % gridDim.x)); }
    DUP(7) { const Ctx X = mkctx(lds); float lam; { const float p1 = inp(19)[X.lane] * inp(20)[X.lane], p2 = inp(21)[X.lane] * inp(22)[X.lane]; lam = expf(wave_sum(p1)) - expf(wave_sum(p2)) + 0.2f; }
        for (int it = blockIdx.x; it < 512; it += gridDim.x) da_item(a, X, it, lam);
        for (int j = (int)((blockIdx.x + 64u) % gridDim.x); j < 64; j += gridDim.x) da_item(a, X, 512 + j, lam); }
    SEAM();
    ON(8) { EpiResid E{inp(2), inp(0), MOD0P, 4096, XRESP, 0, DM / 64, WSP(float, WS_PART)}; run_gemm_mix(lds, WSP(bf16, WS_MIX), WSP(const bf16, WS_WOUT0), DM, E); }
    SEAM();
    ON(9) { const Ctx X = mkctx(lds); norm_mod_phase(X, XRESP, XRESBP, inp(7), MOD0P, 6144, 8192, WSP(bf16, WS_H), 0, MROWS, WSP(float, WS_PART)); }
    SEAM();
    ON(10) { EpiSwiGLU E{WSP(bf16, WS_BIG), 0}; run_gemm(lds, WSP(bf16, WS_H), WSP(const bf16, WS_WUP0), MROWS, 2 * DFF, DM, E); }
    DUP(10) { EpiSwiGLU E{WSP(bf16, WS_BIG), 0}; run_gemm(lds, WSP(bf16, WS_H), WSP(const bf16, WS_WUP0), MROWS, 2 * DFF, DM, E); }
    ON(10) { __syncthreads(); const Ctx X = mkctx(lds); adaln_layer(X, 1, (int)(((MROWS / 256) * (2 * DFF / 256)) % gridDim.x)); }
    SEAM();
    ON(11) { EpiResid E{XRESP, XRESBP, MOD0P, 10240, XRESP, 0, DFF / 64, WSP(float, WS_PART)}; run_gemm_mix(lds, WSP(bf16, WS_BIG), WSP(const bf16, WS_WDN0), DFF, E); }
    SEAM();
    ON(12) { const Ctx X = mkctx(lds); norm_mod_phase(X, XRESP, XRESBP, inp(6) + DM, MOD1P, 0, 2048, WSP(bf16, WS_H), 0, MROWS, WSP(float, WS_PART)); }
    SEAM();
    ON(13) { EpiBf16N E{WSP(bf16, WS_BIG), NIN1}; run_gemm(lds, WSP(bf16, WS_H), WSP(const bf16, WS_WIN1), MROWS, NIN1, DM, E); }
    ON(13) { __syncthreads(); const Ctx X = mkctx(lds); convert_by_light(X, 3, (int)(((MROWS / 256) * (NIN1 / 256)) % gridDim.x)); }
    DUP(13) { EpiBf16N E{WSP(bf16, WS_BIG), NIN1}; run_gemm(lds, WSP(bf16, WS_H), WSP(const bf16, WS_WIN1), MROWS, NIN1, DM, E); }
    SEAM();
    ON(14) { const Ctx X = mkctx(lds); for (int it = blockIdx.x; it < 512; it += gridDim.x) na_item(a, X, it); }
    DUP(14) { const Ctx X = mkctx(lds); for (int it = blockIdx.x; it < 512; it += gridDim.x) na_item(a, X, it); }
    SEAM();
    ON(15) { EpiResid E{XRESP, XRESBP, MOD1P, 4096, XRESP, CROWS, DM / 64, nullptr}; run_gemm(lds, WSP(bf16, WS_MIX) + (size_t)CROWS * DM, WSP(const bf16, WS_WOUT1), MROWS - CROWS, DM, DM, E); }
    SEAM();
    ON(16) { const Ctx X = mkctx(lds); norm_mod_phase(X, XRESP, XRESBP, inp(7) + DM, MOD1P, 6144, 8192, WSP(bf16, WS_H), CROWS, MROWS); }
    SEAM();
    ON(17) { EpiSwiGLU E{WSP(bf16, WS_BIG), CROWS}; run_gemm(lds, WSP(bf16, WS_H) + (size_t)CROWS * DM, WSP(const bf16, WS_WUP1), MROWS - CROWS, 2 * DFF, DM, E); }
    DUP(17) { EpiSwiGLU E{WSP(bf16, WS_BIG), CROWS}; run_gemm(lds, WSP(bf16, WS_H) + (size_t)CROWS * DM, WSP(const bf16, WS_WUP1), MROWS - CROWS, 2 * DFF, DM, E); }
    SEAM();
    ON(18) { EpiResid E{XRESP, XRESBP, MOD1P, 10240, XRESP, CROWS, DFF / 64, nullptr}; run_gemm(lds, WSP(bf16, WS_BIG) + (size_t)CROWS * DFF, WSP(const bf16, WS_WDN1), MROWS - CROWS, DM, DFF, E); }
    SEAM();
    ON(19) { const Ctx X = mkctx(lds); final_phase(a, X); }
}

extern "C" void kernel_launch(void* const* d_in, const int* in_sizes, int n_in, void* d_out, int out_size, void* d_ws, size_t ws_size, hipStream_t stream) {
    static int grid = 0;
    if (grid == 0) {
        if (n_in != 28 || ws_size < WS_END) { fprintf(stderr, "kernel_launch: unexpected n_in %d / ws_size %zu (need %zu)\n", n_in, ws_size, (size_t)WS_END); grid = -1; return; }
        int dev = 0, cus = 0, per_cu = 0;
        if (hipGetDevice(&dev) != hipSuccess || hipDeviceGetAttribute(&cus, hipDeviceAttributeMultiprocessorCount, dev) != hipSuccess) { grid = -1; return; }
        if (hipFuncSetAttribute((const void*)fwd_kernel, hipFuncAttributeMaxDynamicSharedMemorySize, LDS_BYTES) != hipSuccess) { fprintf(stderr, "kernel_launch: hipFuncSetAttribute failed\n"); grid = -1; return; }
        if (hipOccupancyMaxActiveBlocksPerMultiprocessor(&per_cu, (const void*)fwd_kernel, 512, LDS_BYTES) != hipSuccess || per_cu < 1) { fprintf(stderr, "kernel_launch: occupancy query gave %d\n", per_cu); per_cu = 1; }
        (void)hipGetLastError();
        grid = cus * per_cu;
    }
    if (grid < 0) return;
    Args a{};
    for (int i = 0; i < 28; ++i) a.in[i] = (const float*)d_in[i];
    a.out = (float*)d_out; a.ws = (unsigned char*)d_ws;
    void* args[] = {&a};
    hipError_t e = hipLaunchCooperativeKernel((const void*)fwd_kernel, dim3(grid), dim3(512), args, LDS_BYTES, stream);
    if (e != hipSuccess) fprintf(stderr, "kernel_launch: cooperative launch failed: %s (grid %d)\n", hipGetErrorString(e), grid);
}
```

```cpp
#include <hip/hip_runtime.h>
#include <hip/hip_cooperative_groups.h>
#include <cstdio>
#include <cstdint>
namespace cg = cooperative_groups;
namespace pg8 {
#define PG8_LAS __attribute__((address_space(3)))
typedef unsigned short bf16_t;
typedef short bf16x8 __attribute__((ext_vector_type(8)));
typedef float f32x4 __attribute__((ext_vector_type(4)));
typedef unsigned u32x4 __attribute__((ext_vector_type(4)));
constexpr int BM = 256, BK = 64, HALF = 128, HTB = HALF * BK * 2  , STAGE_BYTES = 8 * HTB, NXCD = 8, WGM = 4;

__host__ __device__ __forceinline__ int lds_byte(int r, int c) { const int st = (r >> 4) * 2 + (c >> 5), rr = r & 15, cc = c & 31, ob = rr * 64 + cc * 2; return st * 1024 + (ob ^ (((ob >> 9) & 1) << 5)); }
__host__ __device__ __forceinline__ void stage_rc(int b, int& R, int& C) { const int st = b / 1024, sb = b % 1024, swz = sb ^ (((sb >> 9) & 1) << 5); R = (st >> 1) * 16 + swz / 64; C = (st & 1) * 32 + (swz % 64) / 2; }
__host__ __device__ __forceinline__ int perm32(int rho) { const int n = rho >> 4, i = rho & 15; return 8 * (i >> 2) + 4 * n + (i & 3); }

struct Unit { int pm, pn, koff, nt; };
struct Gemm { const bf16_t* A; const bf16_t* Bt; int M, N, K; };

struct StaticOrder {
    int nM, nN, nwg, G, c, ntf;
    __host__ __device__ void init(int M, int N, int G_, int c_) { nM = M / BM; nN = N / BM; nwg = nM * nN; G = G_; c = c_; }
    __host__ __device__ bool next(int i, Unit& u) const {
        const long L = (long)i * G + c; if (L >= nwg) return false;
        int wgid = (int)L; { const int q = nwg / NXCD, r = nwg % NXCD, xcd = wgid % NXCD, off = wgid / NXCD; wgid = (xcd < r ? xcd * (q + 1) : r * (q + 1) + (xcd - r) * q) + off; }
        const int nig = WGM * nN, gid = wgid / nig, fm = gid * WGM, gsz = (nM - fm) < WGM ? (nM - fm) : WGM;
        u.pm = fm + ((wgid % nig) % gsz); u.pn = (wgid % nig) / gsz; u.koff = 0; u.nt = ntf; return true;
    }
    __device__ __forceinline__ void a_ready(const Unit&) const {}
    __device__ __forceinline__ void done(const Unit&) const {}
};
__device__ __forceinline__ unsigned cvt_pk_bf16(float lo, float hi) { unsigned r; asm volatile("v_cvt_pk_bf16_f32 %0, %1, %2" : "=v"(r) : "v"(lo), "v"(hi)); return r; }
typedef float f32x2 __attribute__((ext_vector_type(2)));
__device__ __forceinline__ f32x2 gelu_pk(f32x2 v) {
    const f32x2 av = __builtin_elementwise_abs(v), d = av * 0.2316418882f + 1.0f;
    f32x2 t; t.x = __builtin_amdgcn_rcpf(d.x); t.y = __builtin_amdgcn_rcpf(d.y);
    f32x2 q = t * 0.5307027145f + (-0.7265760135f); q = q * t + 0.7107068705f; q = q * t + (-0.142248368f); q = q * t + 0.127414796f; q = q * t;
    const f32x2 s = (v * v) * (-0.72134752044f);
    f32x2 e; e.x = __builtin_amdgcn_exp2f(s.x); e.y = __builtin_amdgcn_exp2f(s.y);
    const f32x2 m = v * (q * e), r = v - m;
    f32x2 o; o.x = v.x < 0.f ? m.x : r.x; o.y = v.y < 0.f ? m.y : r.y; return o;
}

struct EpiF32 {
    static constexpr bool PERM = false, AFTER_DRAIN = false;
    float* C; int ldc; const float* bias;
    __device__ __forceinline__ void operator()(const f32x4 (&acc)[2][2][4][2], const Unit& u, int wr, int wc, int fr, int fq) const {
        const int row0 = u.pm * BM + wr * 64 + fr, col0 = u.pn * BM + wc * 32 + 4 * fq;
        f32x4 bv[2][2];
#pragma unroll
        for (int bj = 0; bj < 2; ++bj)
#pragma unroll
            for (int n = 0; n < 2; ++n) bv[bj][n] = bias ? *(const f32x4*)(bias + col0 + bj * HALF + n * 16) : (f32x4){0.f, 0.f, 0.f, 0.f};
#pragma unroll
        for (int ai = 0; ai < 2; ++ai)
#pragma unroll
            for (int m = 0; m < 4; ++m) { float* rowp = C + (size_t)(row0 + ai * HALF + m * 16) * ldc + col0;
#pragma unroll
                for (int bj = 0; bj < 2; ++bj)
#pragma unroll
                    for (int n = 0; n < 2; ++n) *(f32x4*)(rowp + bj * HALF + n * 16) = acc[ai][bj][m][n] + bv[bj][n]; }
    }
};
template <int ACT  > struct EpiBf16 {
    static constexpr bool PERM = true, AFTER_DRAIN = false;
    bf16_t* O; int ldc; const float* bias; int split_cols; size_t split_stride;
    __device__ __forceinline__ void operator()(const f32x4 (&acc)[2][2][4][2], const Unit& u, int wr, int wc, int fr, int fq) const {
        const int row0 = u.pm * BM + wr * 64 + fr; int colt = u.pn * BM; bf16_t* base = O;
        if (split_cols) { const int t = colt / split_cols; base += (size_t)t * split_stride; colt -= t * split_cols; }
        const int col0 = colt + wc * 32 + 8 * fq, bcol0 = u.pn * BM + wc * 32 + 8 * fq;
        f32x4 bv[2][2];
#pragma unroll
        for (int bj = 0; bj < 2; ++bj)
#pragma unroll
            for (int n = 0; n < 2; ++n) bv[bj][n] = bias ? *(const f32x4*)(bias + bcol0 + bj * HALF + 4 * n) : (f32x4){0.f, 0.f, 0.f, 0.f};
#pragma unroll
        for (int ai = 0; ai < 2; ++ai)
#pragma unroll
            for (int m = 0; m < 4; ++m) { bf16_t* rowp = base + (size_t)(row0 + ai * HALF + m * 16) * ldc + col0;
#pragma unroll
                for (int bj = 0; bj < 2; ++bj) { f32x4 v0 = acc[ai][bj][m][0] + bv[bj][0], v1 = acc[ai][bj][m][1] + bv[bj][1];
                    if (ACT == 1) { f32x2 a = gelu_pk((f32x2){v0[0], v0[1]}), b = gelu_pk((f32x2){v0[2], v0[3]}), c = gelu_pk((f32x2){v1[0], v1[1]}), d = gelu_pk((f32x2){v1[2], v1[3]});
                        v0 = (f32x4){a.x, a.y, b.x, b.y}; v1 = (f32x4){c.x, c.y, d.x, d.y}; }
                    if (ACT == 2) {
#pragma unroll
                        for (int j = 0; j < 4; ++j) { v0[j] = 0.5f * v0[j] * (1.0f + erff(v0[j] * 0.70710678f)); v1[j] = 0.5f * v1[j] * (1.0f + erff(v1[j] * 0.70710678f)); } }
                    u32x4 w; w.x = cvt_pk_bf16(v0[0], v0[1]); w.y = cvt_pk_bf16(v0[2], v0[3]); w.z = cvt_pk_bf16(v1[0], v1[1]); w.w = cvt_pk_bf16(v1[2], v1[3]);
                    *(u32x4*)(rowp + bj * HALF) = w; } }
    }
};

template <class Epi, class Sched, bool STAMP = false>
__device__ __forceinline__ void gemm_phase(PG8_LAS unsigned char* lds, const Gemm g, const Sched& S, const Epi& E, unsigned long long* stamps) {
    int tid_ = threadIdx.x; asm volatile("" : "+v"(tid_)); const int tid = tid_, wid = __builtin_amdgcn_readfirstlane(tid >> 6), lane = tid & 63, wr = wid >> 2, wc = wid & 3, fr = lane & 15, fq = lane >> 4;
    const int K = g.K;
    int ts_lo = 0, ts_hi = 0, nts = 0; const unsigned long long rt_entry = STAMP ? (unsigned long long)wall_clock64() : 0ull;
#define PG8_STAMP() do { if (STAMP && wid == 0 && nts < 64) { const unsigned long long _c = (unsigned long long)clock64(); \
        ts_lo = (lane == nts) ? (int)(unsigned)_c : ts_lo; ts_hi = (lane == nts) ? (int)(unsigned)(_c >> 32) : ts_hi; ++nts; } } while (0)
    PG8_STAMP();
    unsigned voffA[2], voffB[2];
#pragma unroll
    for (int i = 0; i < 2; ++i) { int R, C; stage_rc(tid * 16 + i * 8192, R, C); const int Rb = Epi::PERM ? ((R & ~31) + perm32(R & 31)) : R;
        voffA[i] = (unsigned)(R * K + C) * 2u; voffB[i] = (unsigned)(Rb * K + C) * 2u; }
    const size_t kstep = (size_t)(BK * 2);
    const size_t hstep = (size_t)HALF * K * 2;
    const size_t tstep = 2 * hstep;
    const unsigned ldsw = (unsigned)wid * 1024u;
    const int aoff = lds_byte(wr * 64 + fr, fq * 8), boff = lds_byte(wc * 32 + fr, fq * 8);
#define PG8_SA(b, h) (((b) * 2 + (h)) * HTB)
#define PG8_SB(b, h) ((4 + (b) * 2 + (h)) * HTB)
#define PG8_STAGE(bufoff, gbase, voff) do { _Pragma("unroll") for (int _i = 0; _i < 2; ++_i) \
        __builtin_amdgcn_global_load_lds((const unsigned*)((const char*)(gbase) + (voff)[_i]), (PG8_LAS unsigned*)(lds + (bufoff) + ldsw + _i * 8192), 16, 0, 0); } while (0)
#define PG8_LDA(dst, b, h) do { _Pragma("unroll") for (int m = 0; m < 4; ++m) _Pragma("unroll") for (int k = 0; k < 2; ++k) dst[m][k] = *(const PG8_LAS bf16x8*)(lds + PG8_SA(b, h) + aoff + m * 2048 + k * 1024); } while (0)
#define PG8_LDB(dst, b, h) do { _Pragma("unroll") for (int n = 0; n < 2; ++n) _Pragma("unroll") for (int k = 0; k < 2; ++k) dst[n][k] = *(const PG8_LAS bf16x8*)(lds + PG8_SB(b, h) + boff + n * 2048 + k * 1024); } while (0)
#define PG8_MMA(ai, bj, At, Bt) do { __builtin_amdgcn_s_setprio(1); _Pragma("unroll") for (int m = 0; m < 4; ++m) _Pragma("unroll") for (int n = 0; n < 2; ++n) _Pragma("unroll") for (int k = 0; k < 2; ++k) \
        acc[ai][bj][m][n] = __builtin_amdgcn_mfma_f32_16x16x32_bf16(Bt[n][k], At[m][k], acc[ai][bj][m][n], 0, 0, 0); __builtin_amdgcn_s_setprio(0); } while (0)
#define PG8_WAIT_V(n) asm volatile("s_waitcnt vmcnt(" #n ")" ::: "memory")
#define PG8_WAIT_L(n) asm volatile("s_waitcnt lgkmcnt(" #n ")" ::: "memory")
#define PG8_BAR __builtin_amdgcn_s_barrier()
#define PG8_SCHED __builtin_amdgcn_sched_barrier(0)
    Unit cur, nxt; int ui = 0;
    if (!S.next(0, cur)) return;
    f32x4 acc[2][2][4][2];
#pragma unroll
    for (int a = 0; a < 2; ++a)
#pragma unroll
        for (int b = 0; b < 2; ++b)
#pragma unroll
            for (int m = 0; m < 4; ++m)
#pragma unroll
                for (int n = 0; n < 2; ++n) acc[a][b][m][n] = (f32x4){0.f, 0.f, 0.f, 0.f};
    bf16x8 At[4][2], B0[2][2], B1[2][2];
    const char* cA = (const char*)g.A + (size_t)cur.pm * tstep + cur.koff; const char* cB = (const char*)g.Bt + (size_t)cur.pn * tstep + cur.koff;
    S.a_ready(cur);
    PG8_STAGE(PG8_SB(0, 0), cB, voffB); PG8_STAGE(PG8_SB(0, 1), cB + hstep, voffB); PG8_STAGE(PG8_SA(0, 0), cA, voffA); PG8_STAGE(PG8_SA(0, 1), cA + hstep, voffA);
    if (wr == 1) PG8_BAR;
    PG8_WAIT_V(2); PG8_BAR;
    PG8_STAGE(PG8_SB(1, 0), cB + kstep, voffB); PG8_STAGE(PG8_SA(1, 0), cA + kstep, voffA); PG8_STAGE(PG8_SB(1, 1), cB + hstep + kstep, voffB);
    PG8_WAIT_V(6); PG8_BAR;
    PG8_STAMP();
    for (;;) {
        const bool has_next = S.next(ui + 1, nxt);
        const char* nA = has_next ? (const char*)g.A + (size_t)nxt.pm * tstep + nxt.koff : cA; const char* nB = has_next ? (const char*)g.Bt + (size_t)nxt.pn * tstep + nxt.koff : cB;
        const int nt = cur.nt;
        for (int t = 0; t < nt; t += 2) {
            const bool last = (t == nt - 2);
            const char* a1 = cA + (size_t)(t + 1) * kstep;
            const char* a2 = last ? nA : cA + (size_t)(t + 2) * kstep; const char* b2 = last ? nB : cB + (size_t)(t + 2) * kstep;
            const char* a3 = a2 + kstep; const char* b3 = b2 + kstep;
            if (last && has_next) S.a_ready(nxt);
            PG8_LDB(B0, 0, 0); PG8_LDB(B1, 0, 1); PG8_SCHED; PG8_LDA(At, 0, 0); PG8_STAGE(PG8_SA(1, 1), a1 + hstep, voffA);
            PG8_WAIT_V(8); PG8_WAIT_L(0); PG8_BAR; PG8_MMA(0, 0, At, B0); PG8_MMA(0, 1, At, B1); PG8_BAR; PG8_SCHED;
            PG8_LDA(At, 0, 1); PG8_STAGE(PG8_SB(0, 0), b2, voffB); PG8_STAGE(PG8_SB(0, 1), b2 + hstep, voffB); PG8_STAGE(PG8_SA(0, 0), a2, voffA);
            PG8_WAIT_V(8); PG8_WAIT_L(0); PG8_BAR; PG8_MMA(1, 0, At, B0); PG8_MMA(1, 1, At, B1); PG8_BAR; PG8_SCHED;
            PG8_LDB(B0, 1, 0); PG8_LDB(B1, 1, 1); PG8_SCHED; PG8_LDA(At, 1, 0); PG8_STAGE(PG8_SA(0, 1), a2 + hstep, voffA);
            PG8_WAIT_V(8); PG8_WAIT_L(0); PG8_BAR; PG8_MMA(0, 0, At, B0); PG8_MMA(0, 1, At, B1); PG8_BAR; PG8_SCHED;
            PG8_LDA(At, 1, 1); PG8_STAGE(PG8_SB(1, 0), b3, voffB); PG8_STAGE(PG8_SB(1, 1), b3 + hstep, voffB); PG8_STAGE(PG8_SA(1, 0), a3, voffA);
            PG8_WAIT_V(8); PG8_WAIT_L(0); PG8_BAR; PG8_MMA(1, 0, At, B0); PG8_MMA(1, 1, At, B1); PG8_BAR; PG8_SCHED;
        }
        PG8_STAMP();
        if (wr == 0) PG8_BAR;
        if constexpr (!Epi::AFTER_DRAIN) { E(acc, cur, wr, wc, fr, fq); S.done(cur); }
        PG8_STAMP();
        if (!has_next) break;
#pragma unroll
        for (int a = 0; a < 2; ++a)
#pragma unroll
            for (int b = 0; b < 2; ++b)
#pragma unroll
                for (int m = 0; m < 4; ++m)
#pragma unroll
                    for (int n = 0; n < 2; ++n) acc[a][b][m][n] = (f32x4){0.f, 0.f, 0.f, 0.f};
        cur = nxt; cA = nA; cB = nB; ++ui;
        if (wr == 1) PG8_BAR;
    }
    PG8_WAIT_V(0);
    PG8_BAR;
    if constexpr (Epi::AFTER_DRAIN) { E.fused(acc, cur, wr, wc, fr, fq, lds, wid, lane); S.done(cur); }
    PG8_STAMP();
    if (STAMP && wid == 0) { stamps[lane] = lane < nts ? (((unsigned long long)(unsigned)ts_hi << 32) | (unsigned)ts_lo) : 0ull;
        if (lane == 62) stamps[62] = rt_entry; if (lane == 63) stamps[63] = (unsigned long long)wall_clock64(); }
#undef PG8_STAMP
#undef PG8_SA
#undef PG8_SB
#undef PG8_STAGE
#undef PG8_LDA
#undef PG8_LDB
#undef PG8_MMA
#undef PG8_WAIT_V
#undef PG8_WAIT_L
#undef PG8_BAR
#undef PG8_SCHED
}
}
#define DI __device__ __forceinline__
#define LAS __attribute__((address_space(3)))
typedef unsigned short bf16;
typedef short bf16x8 __attribute__((ext_vector_type(8)));
typedef short bf16x4 __attribute__((ext_vector_type(4)));
typedef float f32x4 __attribute__((ext_vector_type(4)));
typedef unsigned u32x4 __attribute__((ext_vector_type(4)));
typedef unsigned u32x2 __attribute__((ext_vector_type(2)));

constexpr int DM = 2048, MROWS = 9216, CROWS = 1024, DFF = 5632, NIN0 = 6400, NIN1 = 6144, ZXP = 6144;
constexpr float EPS = 1e-6f, LOG2E = 1.4426950408889634f;
constexpr size_t MiB = 1u << 20;
constexpr size_t WS_WIN0 = 0, WS_WOUT0 = 25 * MiB, WS_WUP0 = 33 * MiB, WS_WDN0 = 77 * MiB, WS_WIN1 = 99 * MiB, WS_WOUT1 = 123 * MiB, WS_WUP1 = 131 * MiB, WS_WDN1 = 175 * MiB;
constexpr size_t WS_MOD = 197 * MiB, WS_XRES = 198 * MiB  , WS_H = 270 * MiB, WS_MIX = 306 * MiB, WS_BIG = 342 * MiB  ;
constexpr size_t WS_XBC = 567 * MiB, WS_QK = 603 * MiB, WS_V = 639 * MiB, WS_DT = 657 * MiB, WS_ACUM = 659 * MiB, WS_DEC = 661 * MiB, WS_HIN = 662 * MiB, WS_USCR = 698 * MiB  , WS_PART = 730 * MiB  , WS_BAR = 762 * MiB  , WS_END = 763 * MiB;
constexpr int LDS_BYTES = 147456;

struct Args { const float* in[28]; float* out; unsigned char* ws; };
typedef const float* fptr_t;
__device__ __forceinline__ const float* inp(int i) { const volatile __attribute__((address_space(4))) fptr_t* kp = (const volatile __attribute__((address_space(4))) fptr_t*)__builtin_amdgcn_kernarg_segment_ptr(); return kp[i]; }

typedef float f32x2_t __attribute__((ext_vector_type(2)));
typedef __bf16 bf16x2_t __attribute__((ext_vector_type(2)));
DI unsigned pk2(float lo, float hi) { const f32x2_t v = {lo, hi}; return __builtin_bit_cast(unsigned, __builtin_convertvector(v, bf16x2_t)); }
DI unsigned f2bf(float f) { return pk2(f, 0.f) & 0xffffu; }
DI float bf2f(unsigned short b) { return __uint_as_float(((unsigned)b) << 16); }
DI float wave_sum(float v) {
#pragma unroll
    for (int o = 1; o < 64; o <<= 1) v += __shfl_xor(v, o);
    return v; }
DI float silu_f(float v) { return v * __builtin_amdgcn_rcpf(1.f + __expf(-v)); }
DI f32x4 mfma16(bf16x8 a, bf16x8 b, f32x4 c) { return __builtin_amdgcn_mfma_f32_16x16x32_bf16(a, b, c, 0, 0, 0); }
DI int row_batch(int row) { return row < CROWS ? 4 : (row - CROWS) >> 11; }
DI int chunk_row(int b, int c) { return c < 2 ? b * 256 + c * 128 : CROWS + b * 2048 + (c - 2) * 128; }

template <int R, int C> DI void stage_N(LAS bf16* dst, int dp, const bf16* src, size_t gp, int tid) {
#pragma unroll
    for (int ch = tid; ch < R * C / 8; ch += 512) { const int r = ch / (C / 8), c8 = ch % (C / 8);
        *(LAS u32x4*)(dst + r * dp + c8 * 8) = *(const u32x4*)(src + (size_t)r * gp + c8 * 8); }
}
template <int R, int C> DI void stage_T(LAS bf16* dst, int dp, const bf16* src, size_t gp, int tid) {
#pragma unroll
    for (int ch = tid; ch < R * C / 8; ch += 512) { const int r = ch % R, c8 = ch / R;
        const u32x4 v = *(const u32x4*)(src + (size_t)r * gp + c8 * 8);
        LAS bf16* d = dst + (c8 * 8) * dp + r;
        d[0] = (bf16)(v.x & 0xffffu); d[dp] = (bf16)(v.x >> 16); d[2 * dp] = (bf16)(v.y & 0xffffu); d[3 * dp] = (bf16)(v.y >> 16);
        d[4 * dp] = (bf16)(v.z & 0xffffu); d[5 * dp] = (bf16)(v.z >> 16); d[6 * dp] = (bf16)(v.w & 0xffffu); d[7 * dp] = (bf16)(v.w >> 16); }
}
DI bf16x8 lds_frag16(const LAS bf16* p) { return *(const LAS bf16x8*)p; }
DI bf16x8 lds_frag8x2(const LAS bf16* p0, const LAS bf16* p1) { const bf16x4 a = *(const LAS bf16x4*)p0, b = *(const LAS bf16x4*)p1; return __builtin_shufflevector(a, b, 0, 1, 2, 3, 4, 5, 6, 7); }
DI bf16x8 pack8(const f32x4 a, const f32x4 b) { u32x4 w; w.x = pk2(a[0], a[1]); w.y = pk2(a[2], a[3]); w.z = pk2(b[0], b[1]); w.w = pk2(b[2], b[3]); return __builtin_bit_cast(bf16x8, w); }

struct EpiResid {
    static constexpr bool PERM = false, AFTER_DRAIN = false;
    const float* resA; const float* resB; const float* mod; int goff; float* out; int row_base; int ntfull; float* part;
    __device__ __forceinline__ void operator()(const pg8::f32x4 (&acc)[2][2][4][2], const pg8::Unit& u, int wr, int wc, int fr, int fq) const {
        const int rowt = row_base + u.pm * 256; const int brow = row_batch(rowt);
        const int row0 = rowt + wr * 64 + fr, col0 = u.pn * 256 + wc * 32 + 4 * fq;
        const float* gp = mod + (size_t)brow * 12288 + goff + col0;
        f32x4 gv[2][2];
#pragma unroll
        for (int bj = 0; bj < 2; ++bj)
#pragma unroll
            for (int n = 0; n < 2; ++n) gv[bj][n] = *(const f32x4*)(gp + bj * 128 + n * 16);
        const float* const rbase = rowt < CROWS ? resA : resB - (size_t)CROWS * DM;
        if (u.nt != ntfull) {
            float* pb = part + (size_t)(u.koff / (u.nt * 128)) * CROWS * DM;
#pragma unroll
            for (int ai = 0; ai < 2; ++ai)
#pragma unroll
                for (int m = 0; m < 4; ++m) { float* op = pb + (size_t)(row0 + ai * 128 + m * 16) * DM + col0;
#pragma unroll
                    for (int bj = 0; bj < 2; ++bj)
#pragma unroll
                        for (int n = 0; n < 2; ++n) *(f32x4*)(op + bj * 128 + n * 16) = gv[bj][n] * acc[ai][bj][m][n]; }
            return;
        }
#pragma unroll
        for (int ai = 0; ai < 2; ++ai)
#pragma unroll
            for (int m = 0; m < 4; ++m) { const int row = row0 + ai * 128 + m * 16;
                const float* rp = rbase + (size_t)row * DM + col0; float* op = out + (size_t)row * DM + col0;
#pragma unroll
                for (int bj = 0; bj < 2; ++bj)
#pragma unroll
                    for (int n = 0; n < 2; ++n) { const f32x4 rv = *(const f32x4*)(rp + bj * 128 + n * 16); *(f32x4*)(op + bj * 128 + n * 16) = rv + gv[bj][n] * acc[ai][bj][m][n]; } }
    }
};
struct EpiSwiGLU {
    static constexpr bool PERM = true, AFTER_DRAIN = false;
    bf16* O; int row_base;
    __device__ __forceinline__ void operator()(const pg8::f32x4 (&acc)[2][2][4][2], const pg8::Unit& u, int wr, int wc, int fr, int fq) const {
        const int row0 = row_base + u.pm * 256 + wr * 64 + fr, col0 = u.pn * 128 + wc * 32 + 8 * fq;
#pragma unroll
        for (int ai = 0; ai < 2; ++ai)
#pragma unroll
            for (int m = 0; m < 4; ++m) { bf16* op = O + (size_t)(row0 + ai * 128 + m * 16) * DFF + col0;
                f32x4 v0, v1;
#pragma unroll
                for (int j = 0; j < 4; ++j) { const float a0 = acc[ai][0][m][0][j], a1 = acc[ai][0][m][1][j]; v0[j] = a0 * __builtin_amdgcn_rcpf(1.f + __expf(-a0)) * acc[ai][1][m][0][j]; v1[j] = a1 * __builtin_amdgcn_rcpf(1.f + __expf(-a1)) * acc[ai][1][m][1][j]; }
                u32x4 w; w.x = pk2(v0[0], v0[1]); w.y = pk2(v0[2], v0[3]); w.z = pk2(v1[0], v1[1]); w.w = pk2(v1[2], v1[3]);
                *(u32x4*)op = w; }
    }
};
struct EpiInProj0 {
    static constexpr bool PERM = true, AFTER_DRAIN = false;
    bf16* O; float* dtraw;
    __device__ __forceinline__ void operator()(const pg8::f32x4 (&acc)[2][2][4][2], const pg8::Unit& u, int wr, int wc, int fr, int fq) const {
        const int row0 = u.pm * 256 + wr * 64 + fr;
        if (u.pn == 24) {
            if (wc == 0) {
#pragma unroll
                for (int ai = 0; ai < 2; ++ai)
#pragma unroll
                    for (int m = 0; m < 4; ++m) { float* dp = dtraw + (size_t)(row0 + ai * 128 + m * 16) * 32 + 8 * fq; *(f32x4*)dp = acc[ai][0][m][0]; *(f32x4*)(dp + 4) = acc[ai][0][m][1]; } }
            return;
        }
        const int col0 = u.pn * 256 + wc * 32 + 8 * fq;
#pragma unroll
        for (int ai = 0; ai < 2; ++ai)
#pragma unroll
            for (int m = 0; m < 4; ++m) { bf16* rowp = O + (size_t)(row0 + ai * 128 + m * 16) * ZXP + col0;
#pragma unroll
                for (int bj = 0; bj < 2; ++bj) { const f32x4 v0 = acc[ai][bj][m][0], v1 = acc[ai][bj][m][1];
                    u32x4 w; w.x = pk2(v0[0], v0[1]); w.y = pk2(v0[2], v0[3]); w.z = pk2(v1[0], v1[1]); w.w = pk2(v1[2], v1[3]);
                    *(u32x4*)(rowp + bj * 128) = w; } }
    }
};
DI f32x4 bf4_to_f32(u32x2 w) { f32x4 r; r[0] = __uint_as_float(w.x << 16); r[1] = __uint_as_float(w.x & 0xffff0000u); r[2] = __uint_as_float(w.y << 16); r[3] = __uint_as_float(w.y & 0xffff0000u); return r; }
struct EpiBf16N {
    static constexpr bool PERM = true, AFTER_DRAIN = false;
    bf16* O; int ldc;
    __device__ __forceinline__ void operator()(const pg8::f32x4 (&acc)[2][2][4][2], const pg8::Unit& u, int wr, int wc, int fr, int fq) const {
        const int row0 = u.pm * 256 + wr * 64 + fr, col0 = u.pn * 256 + wc * 32 + 8 * fq;
#pragma unroll
        for (int ai = 0; ai < 2; ++ai)
#pragma unroll
            for (int m = 0; m < 4; ++m) { bf16* rowp = O + (size_t)(row0 + ai * 128 + m * 16) * ldc + col0;
#pragma unroll
                for (int bj = 0; bj < 2; ++bj) { const f32x4 v0 = acc[ai][bj][m][0], v1 = acc[ai][bj][m][1];
                    u32x4 w; w.x = pk2(v0[0], v0[1]); w.y = pk2(v0[2], v0[3]); w.z = pk2(v1[0], v1[1]); w.w = pk2(v1[2], v1[3]);
                    *(u32x4*)(rowp + bj * 128) = w; } }
    }
};
struct Ctx { LAS unsigned char* lds; int tid, lane, wave, q, l15, gw, ngw; unsigned char* ws; };

DI void tr_item(const float* W, int K, int N, bf16* WT, int mode, LAS float* scr  , int item, int lane) {
    const int nblk = N / 32, kb = item / nblk, nb = item % nblk, k0 = 128 * kb, n0 = 32 * nb;
    { const int kr = lane >> 3, n4 = (lane & 7) * 4; f32x4 v[16];
#pragma unroll
      for (int i = 0; i < 16; ++i) v[i] = *(const f32x4*)(W + (size_t)(k0 + 8 * i + kr) * N + n0 + n4);
#pragma unroll
      for (int i = 0; i < 16; ++i) { LAS float* d = scr + (8 * i + kr) * 33 + n4; d[0] = v[i][0]; d[1] = v[i][1]; d[2] = v[i][2]; d[3] = v[i][3]; } }
    asm volatile("s_waitcnt lgkmcnt(0)" ::: "memory");
    int d0 = n0;
    if (mode == 1) d0 = n0 < 3072 ? n0 : (n0 < 3104 ? 6144 + (n0 - 3072) : n0 - 32);
    else if (mode == 2) d0 = (n0 / 128) * 256 + (n0 % 128);
    else if (mode == 3) d0 = (n0 / 128) * 256 + 128 + (n0 % 128);
    const int c = lane & 15;
#pragma unroll
    for (int j = 0; j < 8; ++j) { const int n = (lane >> 4) + 4 * j; const LAS float* s = scr + (8 * c) * 33 + n;
        u32x4 o; o.x = pk2(s[0 * 33], s[1 * 33]); o.y = pk2(s[2 * 33], s[3 * 33]); o.z = pk2(s[4 * 33], s[5 * 33]); o.w = pk2(s[6 * 33], s[7 * 33]);
        *(u32x4*)(WT + (size_t)(d0 + n) * K + k0 + 8 * c) = o; }
    asm volatile("s_waitcnt lgkmcnt(0)" ::: "memory");
}
DI void convert_group(const Ctx& X, int grp, int idx, int stride) {
    unsigned char* const wsl = (unsigned char*)inp(29);
    LAS float* scr = (LAS float*)(X.lds + X.wave * 16896);
    constexpr int I_IN0 = 16 * 193, I_SQ = 16 * 64, I_UP = 16 * 176, I_DN = 44 * 64, I_IN1 = 16 * 192;
    if (grp == 0) {
        for (int it = idx; it < I_IN0; it += stride) tr_item(inp(12), 2048, 6176, (bf16*)(wsl + WS_WIN0), 1, scr, it, X.lane);
    } else if (grp == 1) {
        for (int it = idx; it < I_SQ + 2 * I_UP + I_DN; it += stride) { int r = it;
            if (r < I_SQ) { tr_item(inp(24), 2048, 2048, (bf16*)(wsl + WS_WOUT0), 0, scr, r, X.lane); continue; } r -= I_SQ;
            if (r < I_UP) { tr_item(inp(9), 2048, DFF, (bf16*)(wsl + WS_WUP0), 2, scr, r, X.lane); continue; } r -= I_UP;
            if (r < I_UP) { tr_item(inp(10), 2048, DFF, (bf16*)(wsl + WS_WUP0), 3, scr, r, X.lane); continue; } r -= I_UP;
            tr_item(inp(11), DFF, 2048, (bf16*)(wsl + WS_WDN0), 0, scr, r, X.lane); }
    } else if (grp == 2) {
        for (int it = idx; it < I_IN1 + I_SQ; it += stride) { int r = it;
            if (r < I_IN1) { tr_item(inp(25), 2048, 6144, (bf16*)(wsl + WS_WIN1), 0, scr, r, X.lane); continue; } r -= I_IN1;
            tr_item(inp(27), 2048, 2048, (bf16*)(wsl + WS_WOUT1), 0, scr, r, X.lane); }
    } else {
        for (int it = idx; it < 2 * I_UP + I_DN; it += stride) { int r = it;
            if (r < I_UP) { tr_item(inp(9) + (size_t)2048 * DFF, 2048, DFF, (bf16*)(wsl + WS_WUP1), 2, scr, r, X.lane); continue; } r -= I_UP;
            if (r < I_UP) { tr_item(inp(10) + (size_t)2048 * DFF, 2048, DFF, (bf16*)(wsl + WS_WUP1), 3, scr, r, X.lane); continue; } r -= I_UP;
            tr_item(inp(11) + (size_t)2048 * DFF, DFF, 2048, (bf16*)(wsl + WS_WDN1), 0, scr, r, X.lane); }
    }
}
DI void convert_by_light(const Ctx& X, int grp, int first) {
    const int G = (int)gridDim.x; if (first < 0 || first >= G) first = 0;
    if ((int)blockIdx.x >= first) convert_group(X, grp, ((int)blockIdx.x - first) * 8 + X.wave, (G - first) * 8);
}
DI void adaln_layer(const Ctx& X, int l, int first) {
    unsigned char* const wsl = (unsigned char*)inp(29);
    LAS float* cond = (LAS float*)X.lds;
    LAS float* red = (LAS float*)(X.lds + 40960);
    float* MOD = (float*)(wsl + WS_MOD);
    const int G = (int)gridDim.x; if (first < 0 || first >= G) first = 0;
    if ((int)blockIdx.x < first) return;
    for (int i = X.tid; i < 5 * 2048; i += 512) { const float v = i < 8192 ? inp(1)[i] : inp(3)[i - 8192]; cond[i] = silu_f(v); }
    __syncthreads();
    for (int it = (int)blockIdx.x - first; it < 384; it += G - first) {
        const int n0 = it * 32, cq = X.tid & 7, ks = X.tid >> 3;
        const float* W = inp(4) + (size_t)l * 2048 * 12288 + n0 + 4 * cq;
        float acc[5][4];
#pragma unroll
        for (int r = 0; r < 5; ++r)
#pragma unroll
            for (int j = 0; j < 4; ++j) acc[r][j] = 0.f;
#pragma unroll 8
        for (int kk = 0; kk < 32; ++kk) { const int k = ks * 32 + kk; const f32x4 w = *(const f32x4*)(W + (size_t)k * 12288);
#pragma unroll
            for (int r = 0; r < 5; ++r) { const float cv = cond[r * 2048 + k];
#pragma unroll
                for (int j = 0; j < 4; ++j) acc[r][j] += cv * w[j]; } }
#pragma unroll
        for (int r = 0; r < 5; ++r)
#pragma unroll
            for (int j = 0; j < 4; ++j) red[X.tid * 20 + r * 4 + j] = acc[r][j];
        __syncthreads();
        for (int o = X.tid; o < 160; o += 512) { const int r = o / 32, cc = o % 32, cq2 = cc >> 2, ci = cc & 3; float s = 0.f;
            for (int k2 = 0; k2 < 64; ++k2) s += red[(k2 * 8 + cq2) * 20 + r * 4 + ci];
            MOD[(size_t)(l * 5 + r) * 12288 + n0 + cc] = s + inp(5)[l * 12288 + n0 + cc]; }
        __syncthreads();
    }
}
DI void p0_phase(const Args& a, const Ctx& X) {
    unsigned char* const wsl = (unsigned char*)inp(29);
    adaln_layer(X, 0, 0);
    __syncthreads();
    convert_group(X, 0, X.gw, X.ngw);
    { u32x4* z = (u32x4*)(wsl + WS_WIN0 + (size_t)6176 * 2048 * 2); const u32x4 zero = {0u, 0u, 0u, 0u};
      for (int i = blockIdx.x * 512 + X.tid; i < 224 * 2048 * 2 / 16; i += gridDim.x * 512) z[i] = zero; }
}

DI void norm_mod_phase(const Ctx& X, const float* srcA, const float* srcB, const float* g, const float* mod, int shoff, int scoff, bf16* H, int row_lo, int row_hi, const float* part = nullptr) {
    for (int row = row_lo + X.gw; row < row_hi; row += X.ngw) {
        const float* xr = row < CROWS ? srcA + (size_t)row * DM : srcB + (size_t)(row - CROWS) * DM;
        const int brow = row_batch(row); const float* sh = mod + (size_t)brow * 12288 + shoff; const float* sc = mod + (size_t)brow * 12288 + scoff;
        f32x4 v[8]; float s = 0.f;
#pragma unroll
        for (int j = 0; j < 8; ++j) v[j] = ((const f32x4*)xr)[X.lane + 64 * j];
        if (part != nullptr && row < CROWS) {
#pragma unroll
            for (int j = 0; j < 8; ++j) {
#pragma unroll
                for (int ks = 0; ks < 4; ++ks) v[j] += ((const f32x4*)(part + ((size_t)ks * CROWS + row) * DM))[X.lane + 64 * j];
                ((f32x4*)xr)[X.lane + 64 * j] = v[j]; }
        }
#pragma unroll
        for (int j = 0; j < 8; ++j) s += (v[j][0] * v[j][0] + v[j][1] * v[j][1]) + (v[j][2] * v[j][2] + v[j][3] * v[j][3]);
        s = wave_sum(s); const float rstd = 1.f / sqrtf(s * (1.f / DM) + EPS);
#pragma unroll
        for (int j = 0; j < 8; ++j) { const int c4 = X.lane + 64 * j; const f32x4 gg = ((const f32x4*)g)[c4], sv = ((const f32x4*)sc)[c4], hv = ((const f32x4*)sh)[c4];
            f32x4 o; for (int e = 0; e < 4; ++e) o[e] = v[j][e] * rstd * gg[e] * (1.f + sv[e]) + hv[e];
            u32x2 w; w.x = pk2(o[0], o[1]); w.y = pk2(o[2], o[3]); ((u32x2*)(H + (size_t)row * DM))[c4] = w; }
    }
}

DI void post_phase(const Args& a, const Ctx& X) {
    unsigned char* const wsl = (unsigned char*)inp(29);
    LAS float* cs = (LAS float*)X.lds;
    for (int i = X.tid; i < 1024; i += 512) { const int p = i >> 4, j = i & 15; const float inv = powf(10000.f, -(float)j / 16.f); const float ang = (float)p * inv; cs[i] = cosf(ang); cs[1024 + i] = sinf(ang); }
    __syncthreads();
    const bf16* ZX = (const bf16*)(wsl + WS_BIG); const float* DTRAW = (const float*)(wsl + WS_V); bf16* XBC = (bf16*)(wsl + WS_XBC); bf16* QK = (bf16*)(wsl + WS_QK); float* DT = (float*)(wsl + WS_DT);
    const float* cw = inp(13); const float* cb = inp(14); const float* dtb = inp(16);
    for (int item = X.gw; item < (MROWS / 4) * 8; item += X.ngw) {
        const int rg = item >> 3, j = item & 7, row0 = 4 * rg; const bool isctx = row0 < CROWS; const int t0 = isctx ? (row0 & 255) : ((row0 - CROWS) & 2047); const int seg = isctx ? 256 : 2048;
        const int ch = 4 * X.lane + 256 * j; const bf16* zr0 = ZX + (size_t)row0 * ZXP + 1024 + ch; f32x4 xin[8];
#pragma unroll
        for (int i = 0; i < 8; ++i) { const int tt = t0 + i - 2; xin[i] = (tt >= 0 && tt < seg) ? bf4_to_f32(*(const u32x2*)(zr0 + (ptrdiff_t)(i - 2) * ZXP)) : (f32x4){0.f, 0.f, 0.f, 0.f}; }
        f32x4 wv[5];
#pragma unroll
        for (int tap = 0; tap < 5; ++tap) wv[tap] = *(const f32x4*)(cw + tap * 2048 + ch);
        const f32x4 bv = *(const f32x4*)(cb + ch);
#pragma unroll
        for (int r = 0; r < 4; ++r) { f32x4 acc = bv;
#pragma unroll
            for (int tap = 0; tap < 5; ++tap) acc += wv[tap] * xin[r + tap];
            u32x2 w; w.x = pk2(silu_f(acc[0]), silu_f(acc[1])); w.y = pk2(silu_f(acc[2]), silu_f(acc[3])); *(u32x2*)(XBC + (size_t)(row0 + r) * 2048 + ch) = w; }
    }
    for (int row = X.gw; row < MROWS; row += X.ngw) {
        const bool isctx = row < CROWS; const int t = isctx ? (row & 255) : ((row - CROWS) & 2047); const bf16* zr = ZX + (size_t)row * ZXP;
        if (X.lane < 32) { const float v = DTRAW[(size_t)row * 32 + X.lane] + dtb[X.lane]; DT[(size_t)row * 32 + X.lane] = v > 20.f ? v : log1pf(expf(v)); }
        { const int bi = X.lane; const bf16* src = zr + 3072 + 32 * bi; f32x4 u1[4], u2[4];
#pragma unroll
          for (int j = 0; j < 4; ++j) { u1[j] = bf4_to_f32(*(const u32x2*)(src + 4 * j)); u2[j] = bf4_to_f32(*(const u32x2*)(src + 16 + 4 * j)); }
          const float scl = bi < 32 ? 0.125f * LOG2E : 1.f;
          const int p = (bi & 1) ? (t & 63) : (t >> 6);
          f32x4 o1[4], o2[4];
#pragma unroll
          for (int j = 0; j < 4; ++j) { f32x4 cv = {1.f, 1.f, 1.f, 1.f}, sv = {0.f, 0.f, 0.f, 0.f};
              if (!isctx) { cv = *(const LAS f32x4*)(cs + p * 16 + 4 * j); sv = *(const LAS f32x4*)(cs + 1024 + p * 16 + 4 * j); }
              o1[j] = (u1[j] * cv - u2[j] * sv) * scl; o2[j] = (u1[j] * sv + u2[j] * cv) * scl; }
          bf16* dst = QK + (size_t)row * 2048 + 32 * bi;
          *(bf16x8*)dst = pack8(o1[0], o1[1]); *(bf16x8*)(dst + 8) = pack8(o1[2], o1[3]); *(bf16x8*)(dst + 16) = pack8(o2[0], o2[1]); *(bf16x8*)(dst + 24) = pack8(o2[2], o2[3]); }
    }
}

DI void s1_phase(const Args& a, const Ctx& X) {
    unsigned char* const wsl = (unsigned char*)inp(29);
    LAS bf16* BmT = (LAS bf16*)X.lds; LAS bf16* XT = (LAS bf16*)(X.lds + 34816); LAS float* wgt = (LAS float*)(X.lds + 104448);
    const bf16* XBC = (const bf16*)(wsl + WS_XBC); const float* DT = (const float*)(wsl + WS_DT);
    float* ACUM = (float*)(wsl + WS_ACUM); float* DEC = (float*)(wsl + WS_DEC); float* SST = (float*)(wsl + WS_XRES);
    for (int it = blockIdx.x; it < 288; it += gridDim.x) {
        const int b = it / 72, c = (it >> 2) % 18, g = it & 3, r0 = chunk_row(b, c);
        { const int hh = X.wave & 3, dir = X.wave >> 2, h = 4 * g + hh; const float av = -expf(inp(15)[dir * 16 + h]);
          const float d0 = DT[(size_t)(r0 + 2 * X.lane) * 32 + dir * 16 + h], d1 = DT[(size_t)(r0 + 2 * X.lane + 1) * 32 + dir * 16 + h];
          const float v0 = d0 * av, v1 = d1 * av, ps = v0 + v1; float inc = ps;
#pragma unroll
          for (int o = 1; o < 64; o <<= 1) { const float tv = __shfl_up(inc, o); if (X.lane >= o) inc += tv; }
          const float tot = __shfl(inc, 63), exc = inc - ps;
          float a0, a1; if (dir == 0) { a0 = exc + v0; a1 = inc; } else { a0 = tot - exc; a1 = tot - exc - v0; }
          const size_t idx = ((size_t)((b * 18 + c) * 16 + h)) * 2 + dir;
          ACUM[idx * 128 + 2 * X.lane] = a0; ACUM[idx * 128 + 2 * X.lane + 1] = a1;
          wgt[(hh * 2 + dir) * 128 + 2 * X.lane] = d0 * __expf(tot - a0); wgt[(hh * 2 + dir) * 128 + 2 * X.lane + 1] = d1 * __expf(tot - a1);
          if (X.lane == 0) DEC[idx] = expf(tot); }
        stage_T<128, 128>(BmT, 136, XBC + (size_t)r0 * 2048 + 1024 + g * 128, 2048, X.tid);
#pragma unroll
        for (int hh = 0; hh < 4; ++hh) stage_T<128, 64>(XT + hh * 64 * 136, 136, XBC + (size_t)r0 * 2048 + (4 * g + hh) * 64, 2048, X.tid);
        __syncthreads();
        bf16x8 bfr[4];
#pragma unroll
        for (int ks = 0; ks < 4; ++ks) bfr[ks] = lds_frag16(BmT + (16 * X.wave + X.l15) * 136 + 32 * ks + 8 * X.q);
#pragma unroll 1
        for (int hd = 0; hd < 8; ++hd) { const int hh = hd >> 1, dir = hd & 1;
            f32x4 acc[4];
#pragma unroll
            for (int pt = 0; pt < 4; ++pt) acc[pt] = (f32x4){0.f, 0.f, 0.f, 0.f};
            bf16x8 bs[4];
#pragma unroll
            for (int ks = 0; ks < 4; ++ks) { const LAS float* wp = wgt + hd * 128 + 32 * ks + 8 * X.q; const f32x4 w0 = *(const LAS f32x4*)wp, w1 = *(const LAS f32x4*)(wp + 4);
                f32x4 f0, f1;
#pragma unroll
                for (int j = 0; j < 4; ++j) { f0[j] = bf2f((unsigned short)bfr[ks][j]) * w0[j]; f1[j] = bf2f((unsigned short)bfr[ks][4 + j]) * w1[j]; }
                bs[ks] = pack8(f0, f1); }
#pragma unroll
            for (int ks = 0; ks < 4; ++ks)
#pragma unroll
                for (int pt = 0; pt < 4; ++pt) acc[pt] = mfma16(lds_frag16(XT + (hh * 64 + 16 * pt + X.l15) * 136 + 32 * ks + 8 * X.q), bs[ks], acc[pt]);
            const size_t idx = ((size_t)((b * 18 + c) * 16 + 4 * g + hh)) * 2 + dir; float* Sp = SST + idx * 8192;
#pragma unroll
            for (int pt = 0; pt < 4; ++pt)
#pragma unroll
                for (int i = 0; i < 4; ++i) Sp[(16 * pt + 4 * X.q + i) * 128 + 16 * X.wave + X.l15] = acc[pt][i];
        }
        __syncthreads();
    }
}
DI void s2_phase(const Ctx& X) {
    unsigned char* const wsl = (unsigned char*)inp(29);
    const float* DEC = (const float*)(wsl + WS_DEC); const float* SST = (const float*)(wsl + WS_XRES); bf16* HIN = (bf16*)(wsl + WS_HIN);
    for (int e = blockIdx.x * 512 + X.tid; e < 4 * 16 * 2 * 8192; e += gridDim.x * 512) {
        const int pn = e & 8191, dir = (e >> 13) & 1, h = (e >> 14) & 15, b = e >> 18; float hc = 0.f;
#pragma unroll
        for (int i = 0; i < 18; ++i) { const int c = dir == 0 ? i : (i < 2 ? 1 - i : 19 - i); const size_t idx = ((size_t)((b * 18 + c) * 16 + h)) * 2 + dir;
            HIN[idx * 8192 + pn] = (bf16)f2bf(hc); hc = hc * DEC[idx] + SST[idx * 8192 + pn]; }
    }
}
typedef short s16x4 __attribute__((ext_vector_type(4)));
DI bf16x8 lds_tr_frag(const LAS bf16* p0, const LAS bf16* p1) {
    const s16x4 a = __builtin_amdgcn_ds_read_tr16_b64_v4i16((LAS s16x4*)p0), b = __builtin_amdgcn_ds_read_tr16_b64_v4i16((LAS s16x4*)p1);
    return __builtin_shufflevector(a, b, 0, 1, 2, 3, 4, 5, 6, 7); }
DI void softmax_tile(f32x4 (&s)[4], float& m, float& lsum, f32x4 (&o)[8], bf16x8 (&pf)[2]) {
    float mx = -3.0e38f;
#pragma unroll
    for (int mt = 0; mt < 4; ++mt)
#pragma unroll
        for (int i = 0; i < 4; ++i) mx = fmaxf(mx, s[mt][i]);
    mx = fmaxf(mx, __shfl_xor(mx, 16)); mx = fmaxf(mx, __shfl_xor(mx, 32));
    if (__builtin_amdgcn_ballot_w64(mx - m > 6.0f) != 0ull) {
        const float mn = fmaxf(m, mx), alpha = __builtin_amdgcn_exp2f(m - mn); m = mn; lsum *= alpha;
#pragma unroll
        for (int dt = 0; dt < 8; ++dt) o[dt] *= alpha;
    }
    float ps = 0.f;
#pragma unroll
    for (int mt = 0; mt < 4; ++mt)
#pragma unroll
        for (int i = 0; i < 4; ++i) { const float p = __builtin_amdgcn_exp2f(s[mt][i] - m); s[mt][i] = p; ps += p; }
    lsum += ps;
    pf[0] = pack8(s[0], s[1]); pf[1] = pack8(s[2], s[3]);
}
DI void pv_tile(const LAS bf16* vb, const bf16x8 (&pf0)[2], const bf16x8 (&pf1)[2], f32x4 (&o0)[8], f32x4 (&o1)[8]) {
#pragma unroll
    for (int kk = 0; kk < 2; ++kk)
#pragma unroll
        for (int dt = 0; dt < 8; ++dt) { const bf16x8 vf = lds_tr_frag(vb + (32 * kk) * 144 + 16 * dt, vb + (32 * kk + 16) * 144 + 16 * dt);
            o0[dt] = mfma16(vf, pf0[kk], o0[dt]); o1[dt] = mfma16(vf, pf1[kk], o1[dt]); }
}

DI void s3_item(const Args& a, const Ctx& X, int it) {
    unsigned char* const wsl = (unsigned char*)inp(29);
    LAS bf16* Cm = (LAS bf16*)X.lds; LAS bf16* Bm = (LAS bf16*)(X.lds + 34816); LAS bf16* XT = (LAS bf16*)(X.lds + 69632);
    LAS bf16* Hf = (LAS bf16*)(X.lds + 87040); LAS bf16* Gb = (LAS bf16*)(X.lds + 104448);
    LAS float* acf = (LAS float*)(X.lds + 121856); LAS float* acb = acf + 512; LAS float* dtf = acf + 1024; LAS float* dtb = acf + 1536;
    const bf16* XBC = (const bf16*)(wsl + WS_XBC); const float* DT = (const float*)(wsl + WS_DT); const float* ACUM = (const float*)(wsl + WS_ACUM);
    const bf16* HIN = (const bf16*)(wsl + WS_HIN); const bf16* ZX = (const bf16*)(wsl + WS_BIG); bf16* MIX = (bf16*)(wsl + WS_MIX);
    const int b = it / 72, c = (it >> 2) % 18, g = it & 3, r0 = chunk_row(b, c);
    __syncthreads();
    stage_N<128, 128>(Cm, 136, XBC + (size_t)r0 * 2048 + 1536 + g * 128, 2048, X.tid);
    stage_N<128, 128>(Bm, 136, XBC + (size_t)r0 * 2048 + 1024 + g * 128, 2048, X.tid);
    { const int hh = X.tid >> 7, l = X.tid & 127, h = 4 * g + hh; const size_t idx0 = ((size_t)((b * 18 + c) * 16 + h)) * 2;
      acf[hh * 128 + l] = ACUM[idx0 * 128 + l]; acb[hh * 128 + l] = ACUM[(idx0 + 1) * 128 + l];
      dtf[hh * 128 + l] = DT[(size_t)(r0 + l) * 32 + h]; dtb[hh * 128 + l] = DT[(size_t)(r0 + l) * 32 + 16 + h]; }
    __syncthreads();
    const int myl = 16 * X.wave + X.l15;
    bf16x8 cfr[4];
#pragma unroll
    for (int ks = 0; ks < 4; ++ks) cfr[ks] = lds_frag16(Cm + myl * 136 + 32 * ks + 8 * X.q);
    f32x4* USCR = (f32x4*)(wsl + WS_USCR) + (size_t)blockIdx.x * 8192;
    float ss = 0.f;
    const int xr_ = X.tid & 127, xc_ = X.tid >> 7, nr_ = X.tid >> 4, nc_ = (X.tid & 15) * 8;
    u32x4 px0, px1, ph0, ph1, pg0, pg1;
#define S3_LOAD(hh_) do { const int h_ = 4 * g + (hh_); const size_t i0_ = ((size_t)((b * 18 + c) * 16 + h_)) * 2; const bf16* xs_ = XBC + (size_t)(r0 + xr_) * 2048 + h_ * 64; \
        px0 = *(const u32x4*)(xs_ + xc_ * 8); px1 = *(const u32x4*)(xs_ + (xc_ + 4) * 8); \
        ph0 = *(const u32x4*)(HIN + i0_ * 8192 + (size_t)nr_ * 128 + nc_); ph1 = *(const u32x4*)(HIN + i0_ * 8192 + (size_t)(nr_ + 32) * 128 + nc_); \
        pg0 = *(const u32x4*)(HIN + (i0_ + 1) * 8192 + (size_t)nr_ * 128 + nc_); pg1 = *(const u32x4*)(HIN + (i0_ + 1) * 8192 + (size_t)(nr_ + 32) * 128 + nc_); } while (0)
#define S3_PUT_T(v_, c8_) do { LAS bf16* d_ = XT + ((c8_) * 8) * 136 + xr_; d_[0] = (bf16)((v_).x & 0xffffu); d_[136] = (bf16)((v_).x >> 16); d_[2 * 136] = (bf16)((v_).y & 0xffffu); d_[3 * 136] = (bf16)((v_).y >> 16); \
        d_[4 * 136] = (bf16)((v_).z & 0xffffu); d_[5 * 136] = (bf16)((v_).z >> 16); d_[6 * 136] = (bf16)((v_).w & 0xffffu); d_[7 * 136] = (bf16)((v_).w >> 16); } while (0)
    S3_LOAD(0);
#pragma unroll 1
    for (int hh = 0; hh < 4; ++hh) {
        const int h = 4 * g + hh;
        __syncthreads();
        S3_PUT_T(px0, xc_); S3_PUT_T(px1, xc_ + 4);
        *(LAS u32x4*)(Hf + nr_ * 136 + nc_) = ph0; *(LAS u32x4*)(Hf + (nr_ + 32) * 136 + nc_) = ph1;
        *(LAS u32x4*)(Gb + nr_ * 136 + nc_) = pg0; *(LAS u32x4*)(Gb + (nr_ + 32) * 136 + nc_) = pg1;
        __syncthreads();
        if (hh < 3) S3_LOAD(hh + 1);
        const float afl = acf[hh * 128 + myl], abl = acb[hh * 128 + myl];
        f32x4 yv[4], yf[4], yb[4];
#pragma unroll
        for (int pt = 0; pt < 4; ++pt) { yv[pt] = (f32x4){0.f, 0.f, 0.f, 0.f}; yf[pt] = yv[pt]; yb[pt] = yv[pt]; }
#pragma unroll 1
        for (int kk = 0; kk < 4; ++kk) {
            f32x4 mv[2];
#pragma unroll
            for (int hf = 0; hf < 2; ++hf) { const int st = 2 * kk + hf; f32x4 cb = {0.f, 0.f, 0.f, 0.f};
#pragma unroll
                for (int ks = 0; ks < 4; ++ks) cb = mfma16(lds_frag16(Bm + (16 * st + X.l15) * 136 + 32 * ks + 8 * X.q), cfr[ks], cb);
#pragma unroll
                for (int i = 0; i < 4; ++i) { const int s = 16 * st + 4 * X.q + i; float cf = 0.f;
                    if (st <= X.wave) { const float ef = __expf(afl - acf[hh * 128 + s]); cf = (s <= myl) ? dtf[hh * 128 + s] * ef : 0.f; }
                    if (st >= X.wave) { const float eb = __expf(abl - acb[hh * 128 + s]); cf += (s >= myl) ? dtb[hh * 128 + s] * eb : 0.f; }
                    mv[hf][i] = cb[i] * cf; } }
            const bf16x8 mfr = pack8(mv[0], mv[1]);
#pragma unroll
            for (int pt = 0; pt < 4; ++pt) { const LAS bf16* xp = XT + (16 * pt + X.l15) * 136 + 32 * kk + 4 * X.q; yv[pt] = mfma16(lds_frag8x2(xp, xp + 16), mfr, yv[pt]); }
        }
#pragma unroll
        for (int ks = 0; ks < 4; ++ks)
#pragma unroll
            for (int pt = 0; pt < 4; ++pt) { yf[pt] = mfma16(lds_frag16(Hf + (16 * pt + X.l15) * 136 + 32 * ks + 8 * X.q), cfr[ks], yf[pt]);
                yb[pt] = mfma16(lds_frag16(Gb + (16 * pt + X.l15) * 136 + 32 * ks + 8 * X.q), cfr[ks], yb[pt]); }
        const float ef = __expf(afl), eb = __expf(abl), dsk = inp(17)[h];
#pragma unroll
        for (int pt = 0; pt < 4; ++pt) { const int p0 = 16 * pt + 4 * X.q; const f32x4 zv = bf4_to_f32(*(const u32x2*)(ZX + (size_t)(r0 + myl) * ZXP + h * 64 + p0)); f32x4 uv;
#pragma unroll
            for (int i = 0; i < 4; ++i) { const float xv = bf2f(XT[(p0 + i) * 136 + myl]); const float y = yv[pt][i] + ef * yf[pt][i] + eb * yb[pt][i];
                uv[i] = (y + dsk * xv) * silu_f(zv[i]); ss += uv[i] * uv[i]; }
            USCR[(hh * 4 + pt) * 512 + X.tid] = uv; }
    }
    ss += __shfl_xor(ss, 16); ss += __shfl_xor(ss, 32);
    const float rstd = __builtin_amdgcn_rsqf(ss * (1.f / 256.f) + EPS);
#pragma unroll 1
    for (int hh = 0; hh < 4; ++hh)
#pragma unroll
        for (int pt = 0; pt < 4; ++pt) { const int ch = g * 256 + hh * 64 + 16 * pt + 4 * X.q; const f32x4 gg = *(const f32x4*)(inp(18) + ch); const f32x4 uv = USCR[(hh * 4 + pt) * 512 + X.tid];
            u32x2 w; w.x = pk2(uv[0] * rstd * gg[0], uv[1] * rstd * gg[1]); w.y = pk2(uv[2] * rstd * gg[2], uv[3] * rstd * gg[3]);
            *(u32x2*)(MIX + (size_t)(r0 + myl) * 2048 + ch) = w; }
}

#undef S3_LOAD
#undef S3_PUT_T
DI void da_item(const Args& a, const Ctx& X, int it, float lam) {
    unsigned char* const wsl = (unsigned char*)inp(29);
    LAS bf16* KS = (LAS bf16*)X.lds; LAS bf16* VS = (LAS bf16*)(X.lds + 18432); LAS float* EX = (LAS float*)(X.lds + 36864);
    const bf16* QK = (const bf16*)(wsl + WS_QK); const bf16* V = (const bf16*)(wsl + WS_BIG) + 5120; bf16* MIX = (bf16*)(wsl + WS_MIX);
    int b, hp, qb; const bool lat = it < 512;
    if (lat) { b = it >> 7; hp = (it >> 4) & 7; qb = it & 15; } else { const int j = it - 512; b = j >> 4; hp = (j >> 1) & 7; qb = j & 1; }
    const int q0row = lat ? CROWS + b * 2048 + qb * 128 : b * 256 + qb * 128, nkt = lat ? 36 : 4;
    const int e = X.wave & 1, qg = X.wave >> 1;
    bf16x8 qf[2][2];
#pragma unroll
    for (int qt = 0; qt < 2; ++qt)
#pragma unroll
        for (int ks = 0; ks < 2; ++ks) qf[qt][ks] = *(const bf16x8*)(QK + (size_t)(q0row + 32 * qg + 16 * qt + X.l15) * 2048 + (2 * hp + e) * 64 + 32 * ks + 8 * X.q);
    f32x4 o0[8], o1[8];
#pragma unroll
    for (int dt = 0; dt < 8; ++dt) { o0[dt] = (f32x4){0.f, 0.f, 0.f, 0.f}; o1[dt] = o0[dt]; }
    float m0 = -1.0e30f, m1 = -1.0e30f, l0 = 0.f, l1 = 0.f;
    const LAS bf16* kb = KS + e * 64 * 72 + X.l15 * 72 + 8 * X.q;
    const LAS bf16* vb = VS + (4 * X.q + (X.l15 >> 2)) * 144 + 4 * (X.lane & 3);
    const int kr = X.tid >> 3, kc = (X.tid & 7) * 8, vr = X.tid >> 4, vc = (X.tid & 15) * 8;
    u32x4 pk0, pk1, pv0, pv1;
#define DA_LOAD(kt_) do { const int kr0_ = (kt_) < 4 ? b * 256 + 64 * (kt_) : CROWS + b * 2048 + 64 * ((kt_) - 4); \
        pk0 = *(const u32x4*)(QK + (size_t)(kr0_ + kr) * 2048 + 1024 + (2 * hp) * 64 + kc); pk1 = *(const u32x4*)(QK + (size_t)(kr0_ + kr) * 2048 + 1024 + (2 * hp + 1) * 64 + kc); \
        pv0 = *(const u32x4*)(V + (size_t)(kr0_ + vr) * ZXP + hp * 128 + vc); pv1 = *(const u32x4*)(V + (size_t)(kr0_ + 32 + vr) * ZXP + hp * 128 + vc); } while (0)
    DA_LOAD(0);
    for (int kt = 0; kt < nkt; ++kt) {
        __syncthreads();
        *(LAS u32x4*)(KS + kr * 72 + kc) = pk0; *(LAS u32x4*)(KS + 64 * 72 + kr * 72 + kc) = pk1;
        *(LAS u32x4*)(VS + vr * 144 + vc) = pv0; *(LAS u32x4*)(VS + (32 + vr) * 144 + vc) = pv1;
        __syncthreads();
        if (kt + 1 < nkt) DA_LOAD(kt + 1);
        bf16x8 pf0[2], pf1[2];
        { f32x4 s0[4], s1[4];
#pragma unroll
          for (int mt = 0; mt < 4; ++mt) { s0[mt] = (f32x4){0.f, 0.f, 0.f, 0.f}; s1[mt] = s0[mt];
#pragma unroll
              for (int ks = 0; ks < 2; ++ks) { const bf16x8 kf = lds_frag16(kb + 16 * mt * 72 + 32 * ks); s0[mt] = mfma16(kf, qf[0][ks], s0[mt]); s1[mt] = mfma16(kf, qf[1][ks], s1[mt]); } }
          softmax_tile(s0, m0, l0, o0, pf0); softmax_tile(s1, m1, l1, o1, pf1); }
        pv_tile(vb, pf0, pf1, o0, o1);
    }
#undef DA_LOAD
    l0 += __shfl_xor(l0, 16); l0 += __shfl_xor(l0, 32); l1 += __shfl_xor(l1, 16); l1 += __shfl_xor(l1, 32);
    __syncthreads();
    if (e == 1) { const float i0 = lam / l0, i1 = lam / l1;
#pragma unroll
        for (int dt = 0; dt < 8; ++dt) { *(LAS f32x4*)(EX + (32 * qg + X.l15) * 132 + 16 * dt + 4 * X.q) = o0[dt] * i0; *(LAS f32x4*)(EX + (32 * qg + 16 + X.l15) * 132 + 16 * dt + 4 * X.q) = o1[dt] * i1; } }
    __syncthreads();
    if (e == 0) { const float i0 = 1.f / l0, i1 = 1.f / l1; float ss0 = 0.f, ss1 = 0.f;
#pragma unroll
        for (int dt = 0; dt < 8; ++dt) { const f32x4 x0 = *(const LAS f32x4*)(EX + (32 * qg + X.l15) * 132 + 16 * dt + 4 * X.q), x1 = *(const LAS f32x4*)(EX + (32 * qg + 16 + X.l15) * 132 + 16 * dt + 4 * X.q);
            o0[dt] = o0[dt] * i0 - x0; o1[dt] = o1[dt] * i1 - x1;
#pragma unroll
            for (int i = 0; i < 4; ++i) { ss0 += o0[dt][i] * o0[dt][i]; ss1 += o1[dt][i] * o1[dt][i]; } }
        ss0 += __shfl_xor(ss0, 16); ss0 += __shfl_xor(ss0, 32); ss1 += __shfl_xor(ss1, 16); ss1 += __shfl_xor(ss1, 32);
        const float r0 = 0.8f * __builtin_amdgcn_rsqf(ss0 * (1.f / 128.f) + EPS), r1 = 0.8f * __builtin_amdgcn_rsqf(ss1 * (1.f / 128.f) + EPS);
        const float* sg = inp(23);
#pragma unroll
        for (int dt = 0; dt < 8; ++dt) { const int d = 16 * dt + 4 * X.q; const f32x4 gg = *(const f32x4*)(sg + d);
            u32x2 w; w.x = pk2(o0[dt][0] * r0 * gg[0], o0[dt][1] * r0 * gg[1]); w.y = pk2(o0[dt][2] * r0 * gg[2], o0[dt][3] * r0 * gg[3]);
            *(u32x2*)(MIX + (size_t)(q0row + 32 * qg + X.l15) * 2048 + 1024 + hp * 128 + d) = w;
            w.x = pk2(o1[dt][0] * r1 * gg[0], o1[dt][1] * r1 * gg[1]); w.y = pk2(o1[dt][2] * r1 * gg[2], o1[dt][3] * r1 * gg[3]);
            *(u32x2*)(MIX + (size_t)(q0row + 32 * qg + 16 + X.l15) * 2048 + 1024 + hp * 128 + d) = w; } }
}

DI void na_item(const Args& a, const Ctx& X, int it) {
    unsigned char* const wsl = (unsigned char*)inp(29);
    LAS bf16* KS = (LAS bf16*)X.lds; LAS bf16* VS = (LAS bf16*)(X.lds + 17408); LAS float* rpbL = (LAS float*)(X.lds + 35840);
    const bf16* QKV = (const bf16*)(wsl + WS_BIG); bf16* MIX = (bf16*)(wsl + WS_MIX);
    const int b = it >> 7, head = (it >> 3) & 15, rq = it & 7, r = 4 * rq + (X.wave >> 1), chalf = X.wave & 1;
    const int rs = min(max(r - 4, 0), 24), rs_lo = min(max(4 * rq - 4, 0), 24), rs_hi = min(max(4 * rq - 1, 0), 24) + 7, nwin = rs_hi - rs_lo + 1;
    const int qc0 = 32 * chalf + X.l15, qc1 = qc0 + 16, cs0 = min(max(qc0 - 8, 0), 48), cs1 = min(max(qc1 - 8, 0), 48);
    const int qrow0 = CROWS + b * 2048 + r * 64 + qc0;
    __syncthreads();
    { const float* rp = inp(26) + head * 465; for (int i = X.tid; i < 480; i += 512) { const int rr = i >> 5, cc = i & 31; rpbL[i] = cc < 31 ? rp[rr * 31 + cc] * LOG2E : -1.0e30f; } }
    unsigned vm0 = 0u, vm1 = 0u; const int db0 = 4 * X.q - qc0 + 15, db1 = 4 * X.q - qc1 + 15;
#pragma unroll
    for (int mt = 0; mt < 4; ++mt)
#pragma unroll
        for (int i = 0; i < 4; ++i) { const int kc = 16 * mt + 4 * X.q + i; vm0 |= (kc >= cs0 && kc < cs0 + 16) ? (1u << (4 * mt + i)) : 0u; vm1 |= (kc >= cs1 && kc < cs1 + 16) ? (1u << (4 * mt + i)) : 0u; }
    bf16x8 qf[2][4];
#pragma unroll
    for (int qt = 0; qt < 2; ++qt)
#pragma unroll
        for (int ks = 0; ks < 4; ++ks) qf[qt][ks] = *(const bf16x8*)(QKV + (size_t)(qrow0 + 16 * qt) * NIN1 + head * 128 + 32 * ks + 8 * X.q);
    f32x4 o0[8], o1[8];
#pragma unroll
    for (int dt = 0; dt < 8; ++dt) { o0[dt] = (f32x4){0.f, 0.f, 0.f, 0.f}; o1[dt] = o0[dt]; }
    float m0 = -1.0e30f, m1 = -1.0e30f, l0 = 0.f, l1 = 0.f; const float SC = 0.08838834764831845f * LOG2E;
    const LAS bf16* kb = KS + X.l15 * 136 + 8 * X.q;
    const LAS bf16* vb = VS + (4 * X.q + (X.l15 >> 2)) * 144 + 4 * (X.lane & 3);
    const int sr = X.tid >> 4, sc = (X.tid & 15) * 8, ntile = nwin + 4;
    u32x4 pk0, pk1, pv0, pv1;
#define NA_LOAD(ti_) do { const int kr0_ = (ti_) < nwin ? CROWS + b * 2048 + (rs_lo + (ti_)) * 64 : b * 256 + 64 * ((ti_) - nwin); const bf16* base_ = QKV + (size_t)(kr0_ + sr) * NIN1 + head * 128 + sc; \
        pk0 = *(const u32x4*)(base_ + 2048); pk1 = *(const u32x4*)(base_ + 2048 + (size_t)32 * NIN1); pv0 = *(const u32x4*)(base_ + 4096); pv1 = *(const u32x4*)(base_ + 4096 + (size_t)32 * NIN1); } while (0)
    NA_LOAD(0);
    for (int ti = 0; ti < ntile; ++ti) {
        const bool win = ti < nwin; const int ur = rs_lo + ti;
        __syncthreads();
        *(LAS u32x4*)(KS + sr * 136 + sc) = pk0; *(LAS u32x4*)(KS + (32 + sr) * 136 + sc) = pk1;
        *(LAS u32x4*)(VS + sr * 144 + sc) = pv0; *(LAS u32x4*)(VS + (32 + sr) * 144 + sc) = pv1;
        __syncthreads();
        if (ti + 1 < ntile) NA_LOAD(ti + 1);
        if (!win || (ur >= rs && ur < rs + 8)) {
            bf16x8 pf0[2], pf1[2]; const int dr = ur - r + 7;
            { f32x4 s0[4], s1[4];
#pragma unroll
              for (int mt = 0; mt < 4; ++mt) { s0[mt] = (f32x4){0.f, 0.f, 0.f, 0.f}; s1[mt] = s0[mt];
#pragma unroll
                  for (int ks = 0; ks < 4; ++ks) { const bf16x8 kf = lds_frag16(kb + 16 * mt * 136 + 32 * ks); s0[mt] = mfma16(kf, qf[0][ks], s0[mt]); s1[mt] = mfma16(kf, qf[1][ks], s1[mt]); } }
              if (win) {
#pragma unroll
                  for (int mt = 0; mt < 4; ++mt)
#pragma unroll
                      for (int i = 0; i < 4; ++i) { const LAS float* rb = rpbL + dr * 32;
                          const int c0 = (vm0 >> (4 * mt + i)) & 1u ? db0 + 16 * mt + i : 31, c1 = (vm1 >> (4 * mt + i)) & 1u ? db1 + 16 * mt + i : 31;
                          s0[mt][i] = s0[mt][i] * SC + rb[c0]; s1[mt][i] = s1[mt][i] * SC + rb[c1]; } }
              else {
#pragma unroll
                  for (int mt = 0; mt < 4; ++mt) { s0[mt] *= SC; s1[mt] *= SC; } }
              softmax_tile(s0, m0, l0, o0, pf0); softmax_tile(s1, m1, l1, o1, pf1); }
            pv_tile(vb, pf0, pf1, o0, o1);
        }
    }
#undef NA_LOAD
    l0 += __shfl_xor(l0, 16); l0 += __shfl_xor(l0, 32); l1 += __shfl_xor(l1, 16); l1 += __shfl_xor(l1, 32);
    const float i0 = 1.f / l0, i1 = 1.f / l1;
#pragma unroll
    for (int dt = 0; dt < 8; ++dt) { const int d = 16 * dt + 4 * X.q;
        u32x2 w; w.x = pk2(o0[dt][0] * i0, o0[dt][1] * i0); w.y = pk2(o0[dt][2] * i0, o0[dt][3] * i0);
        *(u32x2*)(MIX + (size_t)qrow0 * 2048 + head * 128 + d) = w;
        w.x = pk2(o1[dt][0] * i1, o1[dt][1] * i1); w.y = pk2(o1[dt][2] * i1, o1[dt][3] * i1);
        *(u32x2*)(MIX + (size_t)(qrow0 + 16) * 2048 + head * 128 + d) = w; }
}

DI void final_phase(const Args& a, const Ctx& X) {
    unsigned char* const wsl = (unsigned char*)inp(29);
    const float* XR = (const float*)(wsl + WS_XRES); const float* g = inp(8); float* outp = (float*)inp(28);
    for (int row = CROWS + X.gw; row < MROWS; row += X.ngw) {
        const float* xr = XR + (size_t)row * DM; f32x4 v[8]; float s = 0.f;
#pragma unroll
        for (int j = 0; j < 8; ++j) { v[j] = ((const f32x4*)xr)[X.lane + 64 * j]; s += (v[j][0] * v[j][0] + v[j][1] * v[j][1]) + (v[j][2] * v[j][2] + v[j][3] * v[j][3]); }
        s = wave_sum(s); const float rstd = 1.f / sqrtf(s * (1.f / DM) + EPS);
#pragma unroll
        for (int j = 0; j < 8; ++j) { const int c4 = X.lane + 64 * j; const f32x4 gg = ((const f32x4*)g)[c4]; ((f32x4*)(outp + (size_t)(row - CROWS) * DM))[c4] = v[j] * rstd * gg; }
    }
}

#define XB_TMO      128
#define XB_XCNT(j)  (256  + 64 * (j))
#define XB_XSUB(j)  (1280 + 64 * (j))
#define XB_XGEN(j)  (2304 + 64 * (j))
#define XB_TOP      3328
#define XB_TOPGEN   3392
#define XCD_BAR_WORDS 3456
#define XB_SPIN_CAP (1u << 18)

__device__ __forceinline__ unsigned xb_ld(unsigned* p)              { return __hip_atomic_load(p, __ATOMIC_RELAXED, __HIP_MEMORY_SCOPE_AGENT); }
__device__ __forceinline__ unsigned xb_add(unsigned* p, unsigned v) { return __hip_atomic_fetch_add(p, v, __ATOMIC_RELAXED, __HIP_MEMORY_SCOPE_AGENT); }
__device__ __forceinline__ unsigned xb_xcc_id() { return (unsigned)__builtin_amdgcn_s_getreg((3 << 11) | 20) & 0xFu; }
#define XB_SPIN(cond, bar) do { unsigned _sp = 0; while (cond) { __builtin_amdgcn_s_sleep(1); \
    if ((++_sp & 255u) == 0u) { if (xb_ld(&(bar)[XB_TMO])) break; if (_sp > XB_SPIN_CAP) { atomicAdd(&(bar)[XB_TMO], 1u); break; } } } } while (0)

struct XcdBarrier {
    unsigned* bar; unsigned x;
    volatile LAS unsigned* st;
};

__device__ __forceinline__ XcdBarrier xcd_barrier_post(unsigned* bar, volatile LAS unsigned* st) {
    XcdBarrier b; b.bar = bar; b.x = xb_xcc_id(); b.st = st;
    if (threadIdx.x == 0) (void)xb_add(&bar[XB_XCNT(b.x)], 1u);
    return b;
}
__device__ __forceinline__ void xcd_barrier_complete(unsigned* bar, unsigned x, unsigned& nloc, unsigned& nx) {
    const unsigned G = gridDim.x * gridDim.y * gridDim.z;
    unsigned sum, cnt, mine, sp = 0u;
    for (;;) {
        sum = 0u; cnt = 0u; mine = 0u;
#pragma unroll
        for (unsigned j = 0; j < 16; ++j) { const unsigned c = xb_ld(&bar[XB_XCNT(j)]); sum += c; cnt += (c > 0u) ? 1u : 0u; mine = (j == x) ? c : mine; }
        if (sum == G) break;
        __builtin_amdgcn_s_sleep(1);
        if ((++sp & 255u) == 0u) { if (xb_ld(&bar[XB_TMO])) break; if (sp > XB_SPIN_CAP) { atomicAdd(&bar[XB_TMO], 1u); break; } }
    }
    nloc = mine > 0u ? mine : 1u; nx = cnt > 0u ? cnt : 1u;
}

__device__ __forceinline__ void xcd_barrier(const XcdBarrier& b) {
    asm volatile("s_waitcnt vmcnt(0)" ::: "memory");
    __syncthreads();
    if (threadIdx.x == 0) {
        unsigned* bar = b.bar;
        __builtin_amdgcn_s_waitcnt(0);
        unsigned nloc = b.st[0], nx = b.st[1];
        if (nloc == 0u) { xcd_barrier_complete(bar, b.x, nloc, nx); b.st[0] = nloc; b.st[1] = nx; }
        const unsigned old = xb_add(&bar[XB_XSUB(b.x)], 1u);
        const unsigned gen = old / nloc;
        if (old + 1u == (gen + 1u) * nloc) {
            __builtin_amdgcn_fence(__ATOMIC_RELEASE, "agent");
            asm volatile("s_waitcnt vmcnt(0)" ::: "memory");
            const unsigned og = xb_add(&bar[XB_TOP], 1u);
            const unsigned tg = og / nx;
            if (og + 1u == (tg + 1u) * nx) xb_add(&bar[XB_TOPGEN], 1u);
            else XB_SPIN(xb_ld(&bar[XB_TOPGEN]) == tg, bar);
            __builtin_amdgcn_fence(__ATOMIC_ACQUIRE, "agent");
            xb_add(&bar[XB_XGEN(b.x)], 1u);
            asm volatile("s_waitcnt vmcnt(0)" ::: "memory");
        } else {
            XB_SPIN(xb_ld(&bar[XB_XGEN(b.x)]) == gen, bar);
            __builtin_amdgcn_fence(__ATOMIC_ACQUIRE, "agent");
            asm volatile("s_waitcnt vmcnt(0)" ::: "memory");
        }
    }
    __syncthreads();
}

#define WSP(T, off) ((T*)((unsigned char*)inp(29) + (off)))
#define MOD0P WSP(float, WS_MOD)
#define MOD1P (WSP(float, WS_MOD) + 5 * 12288)
#define XRESP WSP(float, WS_XRES)
#define XRESBP (WSP(float, WS_XRES) + (size_t)CROWS * DM)
#ifndef DUPMASK
#define DUPMASK 0u
#endif
#ifndef PH
#define PH 0xFFFFFFFFu
#endif
#define ON(k) if constexpr ((PH >> (k)) & 1u)
#define DUP(k) if constexpr ((DUPMASK >> (k)) & 1u)
DI Ctx mkctx(LAS unsigned char* lds) {
    Ctx X; int t = threadIdx.x; asm volatile("" : "+v"(t)); X.lds = lds; X.tid = t; X.lane = t & 63; X.wave = __builtin_amdgcn_readfirstlane(t >> 6); X.q = X.lane >> 4; X.l15 = X.lane & 15;
    X.gw = blockIdx.x * 8 + X.wave; X.ngw = gridDim.x * 8; X.ws = nullptr; return X; }
template <class Epi> DI void run_gemm(LAS unsigned char* lds, const bf16* A, const bf16* Bt, int M, int N, int K, const Epi& E) {
    pg8::Gemm g{A, Bt, M, N, K}; pg8::StaticOrder S; S.init(M, N, (int)gridDim.x, (int)blockIdx.x); S.ntf = K / 64;
    pg8::gemm_phase<Epi, pg8::StaticOrder, false>(lds, g, S, E, nullptr);
}
struct MixOrder : pg8::StaticOrder {
    __device__ bool next(int i, pg8::Unit& u) const {
        const long L = (long)i * G + c;
        if (L < nwg) { pg8::StaticOrder::next(i, u); u.pm += 4; return true; }
        const int j = (int)(L - nwg); if (j >= 128) return false;
        u.pm = j >> 5; u.pn = (j >> 2) & 7; u.nt = ntf >> 2; u.koff = (j & 3) * u.nt * 128; return true;
    }
};
template <class Epi> DI void run_gemm_mix(LAS unsigned char* lds, const bf16* A, const bf16* Bt, int K, const Epi& E) {
    pg8::Gemm g{A, Bt, MROWS, DM, K}; MixOrder S; S.init(MROWS - CROWS, DM, (int)gridDim.x, (int)blockIdx.x); S.ntf = K / 64;
    pg8::gemm_phase<Epi, MixOrder, false>(lds, g, S, E, nullptr);
}
__global__ void __launch_bounds__(512) fwd_kernel(Args a) {
    extern __shared__ __attribute__((aligned(16))) unsigned char smem[];
    cg::grid_group grid = cg::this_grid();
    LAS unsigned char* const lds = (LAS unsigned char*)smem;
    volatile LAS unsigned* bst = (volatile LAS unsigned*)(lds + LDS_BYTES - 16);
    if (threadIdx.x < 4) bst[threadIdx.x] = 0u;
    __syncthreads();
    if (blockIdx.x == 0) { unsigned* bw = WSP(unsigned, WS_BAR); for (int i = threadIdx.x; i < XCD_BAR_WORDS; i += 512) bw[i] = 0u; }
#define SEAM() xcd_barrier(bar)
    ON(0) { const Ctx X = mkctx(lds); p0_phase(a, X); }
    DUP(0) { __syncthreads(); const Ctx X = mkctx(lds); p0_phase(a, X); }
    grid.sync();
    XcdBarrier bar = xcd_barrier_post(WSP(unsigned, WS_BAR), bst);
    ON(1) { const Ctx X = mkctx(lds); norm_mod_phase(X, inp(2), inp(0), inp(6), MOD0P, 0, 2048, WSP(bf16, WS_H), 0, MROWS); }
    SEAM();
    ON(2) { EpiInProj0 E{WSP(bf16, WS_BIG), WSP(float, WS_V)}; run_gemm(lds, WSP(bf16, WS_H), WSP(const bf16, WS_WIN0), MROWS, NIN0, DM, E); }
    DUP(2) { EpiInProj0 E{WSP(bf16, WS_BIG), WSP(float, WS_V)}; run_gemm(lds, WSP(bf16, WS_H), WSP(const bf16, WS_WIN0), MROWS, NIN0, DM, E); }
    ON(2) { __syncthreads(); const Ctx X = mkctx(lds); convert_by_light(X, 1, (int)(((MROWS / 256) * (NIN0 / 256)) % gridDim.x)); }
    SEAM();
    ON(3) { const Ctx X = mkctx(lds); post_phase(a, X); }
    DUP(3) { __syncthreads(); const Ctx X = mkctx(lds); post_phase(a, X); }
    SEAM();
    ON(4) { const Ctx X = mkctx(lds); s1_phase(a, X); }
    DUP(4) { const Ctx X = mkctx(lds); s1_phase(a, X); }
    SEAM();
    ON(5) { const Ctx X = mkctx(lds); s2_phase(X); }
    DUP(5) { const Ctx X = mkctx(lds); s2_phase(X); }
    SEAM();
    ON(6) { const Ctx X = mkctx(lds); { const f32x4* src = (const f32x4*)inp(2); f32x4* dst = (f32x4*)XRESP; for (int i = blockIdx.x * 512 + X.tid; i < CROWS * DM / 4; i += gridDim.x * 512) dst[i] = src[i]; }
        for (int it = blockIdx.x; it < 288; it += gridDim.x) s3_item(a, X, it); }
    DUP(6) { const Ctx X = mkctx(lds); for (int it = blockIdx.x; it < 288; it += gridDim.x) s3_item(a, X, it); }
    ON(7) { const Ctx X = mkctx(lds); float lam; { const float p1 = inp(19)[X.lane] * inp(20)[X.lane], p2 = inp(21)[X.lane] * inp(22)[X.lane]; lam = expf(wave_sum(p1)) - expf(wave_sum(p2)) + 0.2f; }
        for (int it = blockIdx.x; it < 512; it += gridDim.x) da_item(a, X, it, lam);
        for (int j = (int)((blockIdx.x + 64u) % gridDim.x); j < 64; j += gridDim.x) da_item(a, X, 512 + j, lam);
        __syncthreads(); convert_by_light(X, 2, (int)(288 % gridDim.x)); }
    DUP(7) { const Ctx X = mkctx(lds); float lam; { const float p1 = inp(19)[X.lane] * inp(20)[X.lane], p2 = inp(21)[X.lane] * inp(22)[X.lane]; lam = expf(wave_sum(p1)) - expf(wave_sum(p2)) + 0.2f; }
        for (int it = blockIdx.x; it < 512; it += gridDim.x) da_item(a, X, it, lam);
        for (int j = (int)((blockIdx.x + 64u) % gridDim.x); j < 64; j += gridDim.x) da_item(a, X, 512 + j, lam); }
    SEAM();
    ON(8) { EpiResid E{inp(2), inp(0), MOD0P, 4096, XRESP, 0, DM / 64, WSP(float, WS_PART)}; run_gemm_mix(lds, WSP(bf16, WS_MIX), WSP(const bf16, WS_WOUT0), DM, E); }
    SEAM();
    ON(9) { const Ctx X = mkctx(lds); norm_mod_phase(X, XRESP, XRESBP, inp(7), MOD0P, 6144, 8192, WSP(bf16, WS_H), 0, MROWS, WSP(float, WS_PART)); }
    SEAM();
    ON(10) { EpiSwiGLU E{WSP(bf16, WS_BIG), 0}; run_gemm(lds, WSP(bf16, WS_H), WSP(const bf16, WS_WUP0), MROWS, 2 * DFF, DM, E); }
    DUP(10) { EpiSwiGLU E{WSP(bf16, WS_BIG), 0}; run_gemm(lds, WSP(bf16, WS_H), WSP(const bf16, WS_WUP0), MROWS, 2 * DFF, DM, E); }
    ON(10) { __syncthreads(); const Ctx X = mkctx(lds); adaln_layer(X, 1, (int)(((MROWS / 256) * (2 * DFF / 256)) % gridDim.x)); }
    SEAM();
    ON(11) { EpiResid E{XRESP, XRESBP, MOD0P, 10240, XRESP, 0, DFF / 64, WSP(float, WS_PART)}; run_gemm_mix(lds, WSP(bf16, WS_BIG), WSP(const bf16, WS_WDN0), DFF, E); }
    SEAM();
    ON(12) { const Ctx X = mkctx(lds); norm_mod_phase(X, XRESP, XRESBP, inp(6) + DM, MOD1P, 0, 2048, WSP(bf16, WS_H), 0, MROWS, WSP(float, WS_PART)); }
    SEAM();
    ON(13) { EpiBf16N E{WSP(bf16, WS_BIG), NIN1}; run_gemm(lds, WSP(bf16, WS_H), WSP(const bf16, WS_WIN1), MROWS, NIN1, DM, E); }
    ON(13) { __syncthreads(); const Ctx X = mkctx(lds); convert_by_light(X, 3, (int)(((MROWS / 256) * (NIN1 / 256)) % gridDim.x)); }
    DUP(13) { EpiBf16N E{WSP(bf16, WS_BIG), NIN1}; run_gemm(lds, WSP(bf16, WS_H), WSP(const bf16, WS_WIN1), MROWS, NIN1, DM, E); }
    SEAM();
    ON(14) { const Ctx X = mkctx(lds); for (int it = blockIdx.x; it < 512; it += gridDim.x) na_item(a, X, it); }
    DUP(14) { const Ctx X = mkctx(lds); for (int it = blockIdx.x; it < 512; it += gridDim.x) na_item(a, X, it); }
    SEAM();
    ON(15) { EpiResid E{XRESP, XRESBP, MOD1P, 4096, XRESP, CROWS, DM / 64, nullptr}; run_gemm(lds, WSP(bf16, WS_MIX) + (size_t)CROWS * DM, WSP(const bf16, WS_WOUT1), MROWS - CROWS, DM, DM, E); }
    SEAM();
    ON(16) { const Ctx X = mkctx(lds); norm_mod_phase(X, XRESP, XRESBP, inp(7) + DM, MOD1P, 6144, 8192, WSP(bf16, WS_H), CROWS, MROWS); }
    SEAM();
    ON(17) { EpiSwiGLU E{WSP(bf16, WS_BIG), CROWS}; run_gemm(lds, WSP(bf16, WS_H) + (size_t)CROWS * DM, WSP(const bf16, WS_WUP1), MROWS - CROWS, 2 * DFF, DM, E); }
    DUP(17) { EpiSwiGLU E{WSP(bf16, WS_BIG), CROWS}; run_gemm(lds, WSP(bf16, WS_H) + (size_t)CROWS * DM, WSP(const bf16, WS_WUP1), MROWS - CROWS, 2 * DFF, DM, E); }
    SEAM();
    ON(18) { EpiResid E{XRESP, XRESBP, MOD1P, 10240, XRESP, CROWS, DFF / 64, nullptr}; run_gemm(lds, WSP(bf16, WS_BIG) + (size_t)CROWS * DFF, WSP(const bf16, WS_WDN1), MROWS - CROWS, DM, DFF, E); }
    SEAM();
    ON(19) { const Ctx X = mkctx(lds); final_phase(a, X); }
}

extern "C" void kernel_launch(void* const* d_in, const int* in_sizes, int n_in, void* d_out, int out_size, void* d_ws, size_t ws_size, hipStream_t stream) {
    static int grid = 0;
    if (grid == 0) {
        if (n_in != 28 || ws_size < WS_END) { fprintf(stderr, "kernel_launch: unexpected n_in %d / ws_size %zu (need %zu)\n", n_in, ws_size, (size_t)WS_END); grid = -1; return; }
        int dev = 0, cus = 0, per_cu = 0;
        if (hipGetDevice(&dev) != hipSuccess || hipDeviceGetAttribute(&cus, hipDeviceAttributeMultiprocessorCount, dev) != hipSuccess) { grid = -1; return; }
        if (hipFuncSetAttribute((const void*)fwd_kernel, hipFuncAttributeMaxDynamicSharedMemorySize, LDS_BYTES) != hipSuccess) { fprintf(stderr, "kernel_launch: hipFuncSetAttribute failed\n"); grid = -1; return; }
        if (hipOccupancyMaxActiveBlocksPerMultiprocessor(&per_cu, (const void*)fwd_kernel, 512, LDS_BYTES) != hipSuccess || per_cu < 1) { fprintf(stderr, "kernel_launch: occupancy query gave %d\n", per_cu); per_cu = 1; }
        (void)hipGetLastError();
        grid = cus * per_cu;
    }
    if (grid < 0) return;
    Args a{};
    for (int i = 0; i < 28; ++i) a.in[i] = (const float*)d_in[i];
    a.out = (float*)d_out; a.ws = (unsigned char*)d_ws;
    void* args[] = {&a};
    hipError_t e = hipLaunchCooperativeKernel((const void*)fwd_kernel, dim3(grid), dim3(512), args, LDS_BYTES, stream);
    if (e != hipSuccess) fprintf(stderr, "kernel_launch: cooperative launch failed: %s (grid %d)\n", hipGetErrorString(e), grid);
}
```
